# Optimizing an MI355X kernel written in HIP

```python
import math
import jax, jax.numpy as jnp
from jax import lax
import numpy as np

D_MODEL = 1024
BATCH = 8
SEQ = 4096
DEPTH = 2

HEAD_DIM = 64
ROPE_THETA = 10000.0
SWA_HEADS = 16
SWA_KV_HEADS = 4
SWA_WINDOW = 128
SWA_BLOCK = 128
SWA_Q = SWA_HEADS * HEAD_DIM
SWA_KV = SWA_KV_HEADS * HEAD_DIM
SWA_IN = SWA_Q + 2 * SWA_KV
NSA_HEADS = 16
NSA_KV_HEADS = 4
CMP_LEN = 32
CMP_STRIDE = 16
CMP_HIDDEN = 256
SEL_BLOCK = 64
SEL_TOPN = 16
NSA_WINDOW = 512
NSA_QCHUNK = 32
SEL_FORCE = 1e4
NSA_Q = NSA_HEADS * HEAD_DIM
NSA_KV = NSA_KV_HEADS * HEAD_DIM
NSA_IN = NSA_Q + 6 * NSA_KV + 3 * NSA_HEADS
D_FF = 3584
N_EXPERTS = 8
TOP_K = 2
DN_ALPHA = (2 * DEPTH) ** 0.25
DN_BETA = (8 * DEPTH) ** -0.25
LN_EPS = 1e-5
NEG_INF = -1e30
N_EVEN = (DEPTH + 1) // 2
N_ODD = DEPTH // 2

kernel_name = 'hybrid_swa_sink_nsa_moe_deepnorm'


def _layer_norm(x, g, b):
    xf = x.astype(jnp.float32)
    mu = jnp.mean(xf, axis=-1, keepdims=True)
    var = jnp.mean(jnp.square(xf - mu), axis=-1, keepdims=True)
    return ((xf - mu) * lax.rsqrt(var + LN_EPS)).astype(x.dtype) * g + b


def _rope_tables(seq):
    inv = 1.0 / (ROPE_THETA ** (jnp.arange(0, HEAD_DIM, 2, dtype=jnp.float32) / HEAD_DIM))
    ang = jnp.arange(seq, dtype=jnp.float32)[:, None] * inv[None, :]
    return jnp.cos(ang), jnp.sin(ang)


def _rope(x, cos, sin):
    c = cos[None, :, None, :].astype(x.dtype)
    s = sin[None, :, None, :].astype(x.dtype)
    x1, x2 = jnp.split(x, 2, axis=-1)
    return jnp.concatenate([x1 * c - x2 * s, x2 * c + x1 * s], axis=-1)


def _masked_softmax(s, mask):
    s = jnp.where(mask, s, NEG_INF)
    m = jnp.max(s, axis=-1, keepdims=True)
    p = jnp.where(mask, jnp.exp(s - m), 0.0)
    return p / jnp.maximum(jnp.sum(p, axis=-1, keepdims=True), 1e-30)


def _swa_sink_attention(x, w_in, w_out, sinks, cos, sin):
    B, S, _ = x.shape
    G = SWA_HEADS // SWA_KV_HEADS
    nb = S // SWA_BLOCK
    proj = x @ w_in
    q, k, v = jnp.split(proj, [SWA_Q, SWA_Q + SWA_KV], axis=-1)
    q = _rope(q.reshape(B, S, SWA_HEADS, HEAD_DIM), cos, sin)
    k = _rope(k.reshape(B, S, SWA_KV_HEADS, HEAD_DIM), cos, sin)
    v = v.reshape(B, S, SWA_KV_HEADS, HEAD_DIM)
    qb = q.reshape(B, nb, SWA_BLOCK, SWA_KV_HEADS, G, HEAD_DIM)
    kb = k.reshape(B, nb, SWA_BLOCK, SWA_KV_HEADS, HEAD_DIM)
    vb = v.reshape(B, nb, SWA_BLOCK, SWA_KV_HEADS, HEAD_DIM)
    kk = jnp.concatenate([jnp.concatenate([jnp.zeros_like(kb[:, :1]), kb[:, :-1]], axis=1), kb], axis=2)
    vv = jnp.concatenate([jnp.concatenate([jnp.zeros_like(vb[:, :1]), vb[:, :-1]], axis=1), vb], axis=2)
    scores = jnp.einsum('bnqkgd,bnskd->bnkgqs', qb, kk).astype(jnp.float32) * (HEAD_DIM ** -0.5)
    n_i = jnp.arange(nb)[:, None, None]
    q_i = jnp.arange(SWA_BLOCK)[None, :, None] + SWA_BLOCK
    s_i = jnp.arange(2 * SWA_BLOCK)[None, None, :]
    diff = q_i - s_i
    abs_s = n_i * SWA_BLOCK - SWA_BLOCK + s_i
    mask = ((diff >= 0) & (diff < SWA_WINDOW) & (abs_s >= 0))[None, :, None, None]
    sink = sinks.astype(jnp.float32).reshape(1, 1, SWA_KV_HEADS, G, 1, 1)
    s = jnp.where(mask, scores, NEG_INF)
    m = jnp.maximum(jnp.max(s, axis=-1, keepdims=True), sink)
    p = jnp.where(mask, jnp.exp(s - m), 0.0)
    probs = p / (jnp.sum(p, axis=-1, keepdims=True) + jnp.exp(sink - m))
    o = jnp.einsum('bnkgqs,bnskd->bnqkgd', probs.astype(vv.dtype), vv)
    return o.reshape(B, S, SWA_Q) @ w_out


def _overlap_matrix(nc, nsel):
    cs = CMP_STRIDE * np.arange(nc)
    ce = cs + CMP_LEN
    ss = SEL_BLOCK * np.arange(nsel)
    se = ss + SEL_BLOCK
    ov = np.clip(np.minimum(ce[:, None], se[None, :]) - np.maximum(cs[:, None], ss[None, :]), 0, None)
    return jnp.asarray(ov / CMP_STRIDE, dtype=jnp.float32)


def _nsa_attention(x, w_in, w_out, pos_k, pos_v, ck_w1, ck_w2, cv_w1, cv_w2, cos, sin):
    B, S, _ = x.shape
    Hkv = NSA_KV_HEADS
    G = NSA_HEADS // NSA_KV_HEADS
    scale = HEAD_DIM ** -0.5
    proj = x @ w_in
    splits = [NSA_Q + i * NSA_KV for i in range(7)]
    q, kc, vc, ks, vs, kw, vw, gl = jnp.split(proj, splits, axis=-1)
    q = _rope(q.reshape(B, S, NSA_HEADS, HEAD_DIM), cos, sin)
    kc = _rope(kc.reshape(B, S, Hkv, HEAD_DIM), cos, sin)
    ks = _rope(ks.reshape(B, S, Hkv, HEAD_DIM), cos, sin)
    kw = _rope(kw.reshape(B, S, Hkv, HEAD_DIM), cos, sin)
    vc = vc.reshape(B, S, Hkv, HEAD_DIM)
    vs = vs.reshape(B, S, Hkv, HEAD_DIM)
    vw = vw.reshape(B, S, Hkv, HEAD_DIM)
    gates = jax.nn.sigmoid(gl).reshape(B, S, Hkv, G, 3)

    nc = (S - CMP_LEN) // CMP_STRIDE + 1
    idx = CMP_STRIDE * np.arange(nc)[:, None] + np.arange(CMP_LEN)[None, :]

    def compress(t, pos, w1, w2):
        blk = t[:, idx] + pos[None, None, :, None, :]
        flat = blk.transpose(0, 1, 3, 2, 4).reshape(B, nc, Hkv, CMP_LEN * HEAD_DIM)
        return jax.nn.gelu(flat @ w1) @ w2

    kcc = compress(kc, pos_k, ck_w1, ck_w2)
    vcc = compress(vc, pos_v, cv_w1, cv_w2)
    cmp_end = jnp.asarray(idx[:, -1])

    nsel = S // SEL_BLOCK
    topn = min(SEL_TOPN, nsel)
    ov = _overlap_matrix(nc, nsel)
    kblk = ks.reshape(B, nsel, SEL_BLOCK, Hkv, HEAD_DIM).transpose(0, 3, 1, 2, 4)
    vblk = vs.reshape(B, nsel, SEL_BLOCK, Hkv, HEAD_DIM).transpose(0, 3, 1, 2, 4)
    b_i = jnp.arange(B)[:, None, None, None]
    h_i = jnp.arange(Hkv)[None, :, None, None]
    blk_ids = jnp.arange(nsel)

    kw_pad = jnp.pad(kw, ((0, 0), (NSA_WINDOW, 0), (0, 0), (0, 0)))
    vw_pad = jnp.pad(vw, ((0, 0), (NSA_WINDOW, 0), (0, 0), (0, 0)))

    def chunk(ci):
        c0 = ci * NSA_QCHUNK
        tpos = c0 + jnp.arange(NSA_QCHUNK)
        qc = lax.dynamic_slice_in_dim(q, c0, NSA_QCHUNK, axis=1).reshape(B, NSA_QCHUNK, Hkv, G, HEAD_DIM)
        s_c = jnp.einsum('bqkgd,bckd->bkgqc', qc, kcc).astype(jnp.float32) * scale
        p_c = _masked_softmax(s_c, cmp_end[None, :] <= tpos[:, None])
        o_c = jnp.einsum('bkgqc,bckd->bqkgd', p_c.astype(vcc.dtype), vcc)
        imp = jnp.sum(p_c, axis=2) @ ov
        cur = (tpos // SEL_BLOCK)[:, None]
        forced = (blk_ids[None, :] == 0) | (blk_ids[None, :] == cur) | (blk_ids[None, :] == cur - 1)
        imp = jnp.where(forced, SEL_FORCE, imp)
        imp = jnp.where(blk_ids[None, :] <= cur, imp, -1.0)
        _, sel = lax.top_k(imp, topn)
        ksel = kblk[b_i, h_i, sel].reshape(B, Hkv, NSA_QCHUNK, topn * SEL_BLOCK, HEAD_DIM)
        vsel = vblk[b_i, h_i, sel].reshape(B, Hkv, NSA_QCHUNK, topn * SEL_BLOCK, HEAD_DIM)
        spos = (sel[..., None] * SEL_BLOCK + jnp.arange(SEL_BLOCK)).reshape(B, Hkv, NSA_QCHUNK, topn * SEL_BLOCK)
        mask_s = (spos <= tpos[None, None, :, None])[:, :, None]
        s_s = jnp.einsum('bqkgd,bkqsd->bkgqs', qc, ksel).astype(jnp.float32) * scale
        p_s = _masked_softmax(s_s, mask_s)
        o_s = jnp.einsum('bkgqs,bkqsd->bqkgd', p_s.astype(vsel.dtype), vsel)
        kwc = lax.dynamic_slice_in_dim(kw_pad, c0, NSA_WINDOW + NSA_QCHUNK, axis=1)
        vwc = lax.dynamic_slice_in_dim(vw_pad, c0, NSA_WINDOW + NSA_QCHUNK, axis=1)
        wpos = c0 - NSA_WINDOW + jnp.arange(NSA_WINDOW + NSA_QCHUNK)
        diff = tpos[:, None] - wpos[None, :]
        mask_w = (diff >= 0) & (diff < NSA_WINDOW) & (wpos[None, :] >= 0)
        s_w = jnp.einsum('bqkgd,bskd->bkgqs', qc, kwc).astype(jnp.float32) * scale
        p_w = _masked_softmax(s_w, mask_w)
        o_w = jnp.einsum('bkgqs,bskd->bqkgd', p_w.astype(vwc.dtype), vwc)
        g = lax.dynamic_slice_in_dim(gates, c0, NSA_QCHUNK, axis=1)
        o = g[..., 0:1] * o_c + g[..., 1:2] * o_s + g[..., 2:3] * o_w
        return o.reshape(B, NSA_QCHUNK, NSA_Q)

    outs = lax.map(chunk, jnp.arange(S // NSA_QCHUNK))
    o = outs.transpose(1, 0, 2, 3).reshape(B, S, NSA_Q)
    return o @ w_out


def _swiglu(x, w_gate, w_up, w_down):
    return (jax.nn.silu(x @ w_gate) * (x @ w_up)) @ w_down


def _moe(x, router, w_gate, w_up, w_down):
    B, S, D = x.shape
    xt = x.reshape(B * S, D)
    logits = (xt @ router).astype(jnp.float32)
    vals, ids = lax.top_k(logits, TOP_K)
    w = jax.nn.softmax(vals, axis=-1)
    gate = jnp.sum(jax.nn.one_hot(ids, N_EXPERTS, dtype=jnp.float32) * w[..., None], axis=1)
    out = jnp.zeros_like(xt)
    for e in range(N_EXPERTS):
        out = out + gate[:, e:e + 1].astype(xt.dtype) * _swiglu(xt, w_gate[e], w_up[e], w_down[e])
    return out.reshape(B, S, D)


def _normal(k, shape, scale):
    return jax.random.normal(k, shape, jnp.float32) * scale


def setup_inputs(seed: int = 0) -> dict:
    key = jax.random.key(seed)
    ks = jax.random.split(key, 24)
    D = D_MODEL
    a_col = jnp.concatenate([jnp.ones((SWA_Q + SWA_KV,), jnp.float32), jnp.full((SWA_KV,), DN_BETA, jnp.float32)])
    b_col = jnp.concatenate([
        jnp.ones((NSA_Q + NSA_KV,), jnp.float32),
        jnp.full((NSA_KV,), DN_BETA, jnp.float32),
        jnp.ones((NSA_KV,), jnp.float32),
        jnp.full((NSA_KV,), DN_BETA, jnp.float32),
        jnp.ones((NSA_KV,), jnp.float32),
        jnp.full((NSA_KV,), DN_BETA, jnp.float32),
        jnp.ones((3 * NSA_HEADS,), jnp.float32)])
    return {
        'x': _normal(ks[0], (BATCH, SEQ, D), 1.0),
        'a_w_in': _normal(ks[1], (N_EVEN, D, SWA_IN), D ** -0.5) * a_col,
        'a_w_out': _normal(ks[2], (N_EVEN, SWA_Q, D), DN_BETA * SWA_Q ** -0.5),
        'a_sinks': _normal(ks[3], (N_EVEN, SWA_HEADS), 1.0),
        'b_w_in': _normal(ks[4], (N_ODD, D, NSA_IN), D ** -0.5) * b_col,
        'b_w_out': _normal(ks[5], (N_ODD, NSA_Q, D), DN_BETA * NSA_Q ** -0.5),
        'b_cmp_pos_k': _normal(ks[6], (N_ODD, CMP_LEN, HEAD_DIM), 0.1),
        'b_cmp_pos_v': _normal(ks[7], (N_ODD, CMP_LEN, HEAD_DIM), 0.1),
        'b_cmp_k_w1': _normal(ks[8], (N_ODD, CMP_LEN * HEAD_DIM, CMP_HIDDEN), (CMP_LEN * HEAD_DIM) ** -0.5),
        'b_cmp_k_w2': _normal(ks[9], (N_ODD, CMP_HIDDEN, HEAD_DIM), CMP_HIDDEN ** -0.5),
        'b_cmp_v_w1': _normal(ks[10], (N_ODD, CMP_LEN * HEAD_DIM, CMP_HIDDEN), (CMP_LEN * HEAD_DIM) ** -0.5),
        'b_cmp_v_w2': _normal(ks[11], (N_ODD, CMP_HIDDEN, HEAD_DIM), CMP_HIDDEN ** -0.5),
        'ffn_w_gate': _normal(ks[12], (N_EVEN, D, D_FF), D ** -0.5),
        'ffn_w_up': _normal(ks[13], (N_EVEN, D, D_FF), D ** -0.5),
        'ffn_w_down': _normal(ks[14], (N_EVEN, D_FF, D), DN_BETA * D_FF ** -0.5),
        'moe_router': _normal(ks[15], (N_ODD, D, N_EXPERTS), D ** -0.5),
        'moe_w_gate': _normal(ks[16], (N_ODD, N_EXPERTS, D, D_FF), D ** -0.5),
        'moe_w_up': _normal(ks[17], (N_ODD, N_EXPERTS, D, D_FF), D ** -0.5),
        'moe_w_down': _normal(ks[18], (N_ODD, N_EXPERTS, D_FF, D), DN_BETA * D_FF ** -0.5),
        'ln_gain': 1.0 + _normal(ks[19], (DEPTH, 2, D), 0.02),
        'ln_bias': _normal(ks[20], (DEPTH, 2, D), 0.02),
    }


def reference(x, a_w_in, a_w_out, a_sinks, b_w_in, b_w_out, b_cmp_pos_k, b_cmp_pos_v,
              b_cmp_k_w1, b_cmp_k_w2, b_cmp_v_w1, b_cmp_v_w2, ffn_w_gate, ffn_w_up, ffn_w_down,
              moe_router, moe_w_gate, moe_w_up, moe_w_down, ln_gain, ln_bias):
    cos, sin = _rope_tables(x.shape[1])
    for i in range(DEPTH):
        j = i // 2
        if i % 2 == 0:
            h = _swa_sink_attention(x, a_w_in[j], a_w_out[j], a_sinks[j], cos, sin)
        else:
            h = _nsa_attention(x, b_w_in[j], b_w_out[j], b_cmp_pos_k[j], b_cmp_pos_v[j],
                               b_cmp_k_w1[j], b_cmp_k_w2[j], b_cmp_v_w1[j], b_cmp_v_w2[j], cos, sin)
        x = _layer_norm(DN_ALPHA * x + h, ln_gain[i, 0], ln_bias[i, 0])
        if i % 2 == 0:
            f = _swiglu(x, ffn_w_gate[j], ffn_w_up[j], ffn_w_down[j])
        else:
            f = _moe(x, moe_router[j], moe_w_gate[j], moe_w_up[j], moe_w_down[j])
        x = _layer_norm(DN_ALPHA * x + f, ln_gain[i, 1], ln_bias[i, 1])
    return x
```

```cpp
#include <hip/hip_runtime.h>
#include <cstdio>
#include <cstdint>
#include <cmath>

#define LAS __attribute__((address_space(3)))
#define GAS __attribute__((address_space(1)))

typedef unsigned short bf16_t;
typedef short bf16x8 __attribute__((ext_vector_type(8)));
typedef short s16x4 __attribute__((ext_vector_type(4)));
typedef float f32x4 __attribute__((ext_vector_type(4)));
typedef float f32x2 __attribute__((ext_vector_type(2)));
typedef float f32x16 __attribute__((ext_vector_type(16)));
typedef unsigned u32x4 __attribute__((ext_vector_type(4)));
typedef unsigned u32x2 __attribute__((ext_vector_type(2)));

constexpr int NB = 8, SEQ = 4096, TTOK = NB * SEQ, DM = 1024, DFF = 3584, NEXP = 8, HD = 64, NKV = 4;
constexpr float DN_ALPHA = 1.4142135623730951f;
constexpr float LN_EPS = 1e-5f;
constexpr float QSCALE = 0.125f * 1.4426950408889634f;
constexpr float LOG2E = 1.4426950408889634f;
constexpr int NSA_IN = 2608, NSA_IN_PAD = 2816;

__device__ __forceinline__ unsigned cvt_pk_bf16(float lo, float hi) { unsigned r; asm volatile("v_cvt_pk_bf16_f32 %0, %1, %2" : "=v"(r) : "v"(lo), "v"(hi)); return r; }
__device__ __forceinline__ float bf_lo(unsigned w) { return __uint_as_float(w << 16); }
__device__ __forceinline__ float bf_hi(unsigned w) { return __uint_as_float(w & 0xffff0000u); }

namespace pg8 {
constexpr int BM = 256, BK = 64, HALF = 128, HTB = HALF * BK * 2, STAGE_BYTES = 8 * HTB, NXCD = 8, WGM = 8;
__host__ __device__ __forceinline__ int lds_byte(int r, int c) { const int st = (r >> 4) * 2 + (c >> 5), rr = r & 15, cc = c & 31, ob = rr * 64 + cc * 2; return st * 1024 + (ob ^ (((ob >> 9) & 1) << 5)); }
__host__ __device__ __forceinline__ void stage_rc(int b, int& R, int& C) { const int st = b / 1024, sb = b % 1024, swz = sb ^ (((sb >> 9) & 1) << 5); R = (st >> 1) * 16 + swz / 64; C = (st & 1) * 32 + (swz % 64) / 2; }
__host__ __device__ __forceinline__ int perm32(int rho) { const int n = rho >> 4, i = rho & 15; return 8 * (i >> 2) + 4 * n + (i & 3); }

struct Unit { int pm, pn; };
struct Gemm { const bf16_t* A; const bf16_t* Bt; int lda; int K; };

struct StaticOrder {
    int nM, nN, nwg, G, c, pm0;
    __device__ void init(int nM_, int nN_, int G_, int c_, int pm0_) { nM = nM_; nN = nN_; nwg = nM * nN; G = G_; c = c_; pm0 = pm0_; }
    __device__ bool next(int i, Unit& u) const {
        const long L = (long)i * G + c; if (L >= nwg) return false;
        int wgid = (int)L; { const int q = nwg / NXCD, r = nwg % NXCD, xcd = wgid % NXCD, off = wgid / NXCD; wgid = (xcd < r ? xcd * (q + 1) : r * (q + 1) + (xcd - r) * q) + off; }
        const int nig = WGM * nN, gid = wgid / nig, fm = gid * WGM, gsz = (nM - fm) < WGM ? (nM - fm) : WGM;
        u.pm = pm0 + fm + ((wgid % nig) % gsz); u.pn = (wgid % nig) / gsz; return true;
    }
};

template <class Epi, class Sched, class BOff>
__device__ __forceinline__ void gemm_phase(LAS unsigned char* lds, const Gemm g, const Sched& S, const Epi& E, const BOff& boff) {
    const int tid = threadIdx.x, wid = __builtin_amdgcn_readfirstlane(tid >> 6), lane = tid & 63, wr = wid >> 2, wc = wid & 3, fr = lane & 15, fq = lane >> 4;
    const int K = g.K, nt = K / BK;
    unsigned voffA[2], voffB[2];
#pragma unroll
    for (int i = 0; i < 2; ++i) { int R, C; stage_rc(tid * 16 + i * 8192, R, C); const int Rb = Epi::PERM ? ((R & ~31) + perm32(R & 31)) : R;
        voffA[i] = (unsigned)(R * g.lda + C) * 2u; voffB[i] = (unsigned)(Rb * K + C) * 2u; }
    const size_t kstep = (size_t)(BK * 2);
    const size_t hstepA = (size_t)HALF * g.lda * 2, hstepB = (size_t)HALF * K * 2;
    const size_t tstepA = 2 * hstepA;
    const unsigned ldsw = (unsigned)wid * 1024u;
    const int aoff = lds_byte(wr * 64 + fr, fq * 8), boffl = lds_byte(wc * 32 + fr, fq * 8);
#define PG8_SA(b, h) (((b) * 2 + (h)) * HTB)
#define PG8_SB(b, h) ((4 + (b) * 2 + (h)) * HTB)
#define PG8_STAGE(bufoff, gbase, voff) do { _Pragma("unroll") for (int _i = 0; _i < 2; ++_i) \
        __builtin_amdgcn_global_load_lds((const unsigned*)((const char*)(gbase) + (voff)[_i]), (LAS unsigned*)(lds + (bufoff) + ldsw + _i * 8192), 16, 0, 0); } while (0)
#define PG8_LDA(dst, b, h) do { _Pragma("unroll") for (int m = 0; m < 4; ++m) _Pragma("unroll") for (int k = 0; k < 2; ++k) dst[m][k] = *(const LAS bf16x8*)(lds + PG8_SA(b, h) + aoff + m * 2048 + k * 1024); } while (0)
#define PG8_LDB(dst, b, h) do { _Pragma("unroll") for (int n = 0; n < 2; ++n) _Pragma("unroll") for (int k = 0; k < 2; ++k) dst[n][k] = *(const LAS bf16x8*)(lds + PG8_SB(b, h) + boffl + n * 2048 + k * 1024); } while (0)
#define PG8_MMA(ai, bj, At, Bt) do { __builtin_amdgcn_s_setprio(1); _Pragma("unroll") for (int m = 0; m < 4; ++m) _Pragma("unroll") for (int n = 0; n < 2; ++n) _Pragma("unroll") for (int k = 0; k < 2; ++k) \
        acc[ai][bj][m][n] = __builtin_amdgcn_mfma_f32_16x16x32_bf16(Bt[n][k], At[m][k], acc[ai][bj][m][n], 0, 0, 0); __builtin_amdgcn_s_setprio(0); } while (0)
#define PG8_WAIT_V(n) asm volatile("s_waitcnt vmcnt(" #n ")" ::: "memory")
#define PG8_WAIT_L(n) asm volatile("s_waitcnt lgkmcnt(" #n ")" ::: "memory")
#define PG8_BAR __builtin_amdgcn_s_barrier()
#define PG8_SCHED __builtin_amdgcn_sched_barrier(0)
    Unit cur, nxt; int ui = 0;
    if (!S.next(0, cur)) return;
    f32x4 acc[2][2][4][2];
#pragma unroll
    for (int a = 0; a < 2; ++a)
#pragma unroll
        for (int b = 0; b < 2; ++b)
#pragma unroll
            for (int m = 0; m < 4; ++m)
#pragma unroll
                for (int n = 0; n < 2; ++n) acc[a][b][m][n] = (f32x4){0.f, 0.f, 0.f, 0.f};
    bf16x8 At[4][2], B0[2][2], B1[2][2];
    const char* cA = (const char*)g.A + (size_t)cur.pm * tstepA; const char* cB = (const char*)g.Bt + boff(cur);
    PG8_STAGE(PG8_SB(0, 0), cB, voffB); PG8_STAGE(PG8_SB(0, 1), cB + hstepB, voffB); PG8_STAGE(PG8_SA(0, 0), cA, voffA); PG8_STAGE(PG8_SA(0, 1), cA + hstepA, voffA);
    if (wr == 1) PG8_BAR;
    PG8_WAIT_V(2); PG8_BAR;
    PG8_STAGE(PG8_SB(1, 0), cB + kstep, voffB); PG8_STAGE(PG8_SA(1, 0), cA + kstep, voffA); PG8_STAGE(PG8_SB(1, 1), cB + hstepB + kstep, voffB);
    PG8_WAIT_V(6); PG8_BAR;
    for (;;) {
        const bool has_next = S.next(ui + 1, nxt);
        const char* nA = has_next ? (const char*)g.A + (size_t)nxt.pm * tstepA : cA; const char* nB = has_next ? (const char*)g.Bt + boff(nxt) : cB;
        for (int t = 0; t < nt; t += 2) {
            const bool last = (t == nt - 2);
            const char* a1 = cA + (size_t)(t + 1) * kstep;
            const char* a2 = last ? nA : cA + (size_t)(t + 2) * kstep; const char* b2 = last ? nB : cB + (size_t)(t + 2) * kstep;
            const char* a3 = a2 + kstep; const char* b3 = b2 + kstep;
            PG8_LDB(B0, 0, 0); PG8_LDB(B1, 0, 1); PG8_SCHED; PG8_LDA(At, 0, 0); PG8_STAGE(PG8_SA(1, 1), a1 + hstepA, voffA);
            PG8_WAIT_V(8); PG8_WAIT_L(0); PG8_BAR; PG8_MMA(0, 0, At, B0); PG8_MMA(0, 1, At, B1); PG8_BAR; PG8_SCHED;
            PG8_LDA(At, 0, 1); PG8_STAGE(PG8_SB(0, 0), b2, voffB); PG8_STAGE(PG8_SB(0, 1), b2 + hstepB, voffB); PG8_STAGE(PG8_SA(0, 0), a2, voffA);
            PG8_WAIT_V(8); PG8_WAIT_L(0); PG8_BAR; PG8_MMA(1, 0, At, B0); PG8_MMA(1, 1, At, B1); PG8_BAR; PG8_SCHED;
            PG8_LDB(B0, 1, 0); PG8_LDB(B1, 1, 1); PG8_SCHED; PG8_LDA(At, 1, 0); PG8_STAGE(PG8_SA(0, 1), a2 + hstepA, voffA);
            PG8_WAIT_V(8); PG8_WAIT_L(0); PG8_BAR; PG8_MMA(0, 0, At, B0); PG8_MMA(0, 1, At, B1); PG8_BAR; PG8_SCHED;
            PG8_LDA(At, 1, 1); PG8_STAGE(PG8_SB(1, 0), b3, voffB); PG8_STAGE(PG8_SB(1, 1), b3 + hstepB, voffB); PG8_STAGE(PG8_SA(1, 0), a3, voffA);
            PG8_WAIT_V(8); PG8_WAIT_L(0); PG8_BAR; PG8_MMA(1, 0, At, B0); PG8_MMA(1, 1, At, B1); PG8_BAR; PG8_SCHED;
        }
        if (wr == 0) PG8_BAR;
        E(acc, cur, wr, wc, fr, fq);
        if (!has_next) break;
#pragma unroll
        for (int a = 0; a < 2; ++a)
#pragma unroll
            for (int b = 0; b < 2; ++b)
#pragma unroll
                for (int m = 0; m < 4; ++m)
#pragma unroll
                    for (int n = 0; n < 2; ++n) acc[a][b][m][n] = (f32x4){0.f, 0.f, 0.f, 0.f};
        cur = nxt; cA = nA; cB = nB; ++ui;
        if (wr == 1) PG8_BAR;
    }
    PG8_WAIT_V(0);
    PG8_BAR;
#undef PG8_SA
#undef PG8_SB
#undef PG8_STAGE
#undef PG8_LDA
#undef PG8_LDB
#undef PG8_MMA
#undef PG8_WAIT_V
#undef PG8_WAIT_L
#undef PG8_BAR
#undef PG8_SCHED
}
struct BOffPlain { int K; __device__ __forceinline__ size_t operator()(const Unit& u) const { return (size_t)u.pn * 256 * K * 2; } };

struct EpiProj {
    static constexpr bool PERM = true;
    bf16_t* Q; bf16_t* KV; size_t kvstride; float* gates; const float* rope; int ropemask; int gate_tile;
    __device__ __forceinline__ void operator()(const f32x4 (&acc)[2][2][4][2], const Unit& u, int wr, int wc, int fr, int fq) const {
        const int pn = u.pn;
#pragma unroll
        for (int ai = 0; ai < 2; ++ai)
#pragma unroll
            for (int m = 0; m < 4; ++m) {
                const int row = u.pm * BM + ai * HALF + wr * 64 + m * 16 + fr, t = row & (SEQ - 1), b = row >> 12;
#pragma unroll
                for (int bj = 0; bj < 2; ++bj) {
                    const int c0 = bj * HALF + wc * 32 + 8 * fq, hl = c0 >> 6, j4 = (c0 & 63) >> 1;
                    f32x4 v0 = acc[ai][bj][m][0], v1 = acc[ai][bj][m][1];
                    if (pn == gate_tile) {
                        if (c0 < 48) { float* gp = gates + (size_t)row * 48 + c0; f32x4 s0, s1;
#pragma unroll
                            for (int k = 0; k < 4; ++k) { s0[k] = __builtin_amdgcn_rcpf(1.f + __builtin_amdgcn_exp2f(-v0[k] * LOG2E)); s1[k] = __builtin_amdgcn_rcpf(1.f + __builtin_amdgcn_exp2f(-v1[k] * LOG2E)); }
                            *(f32x4*)gp = s0; *(f32x4*)(gp + 4) = s1; }
                    } else {
                        const bool isq = pn < 4; const bool rp = isq || ((ropemask >> (pn - 4)) & 1);
                        bf16_t* dst = isq ? Q + (size_t)row * DM + pn * 256 + hl * 64
                                          : KV + (size_t)(pn - 4) * kvstride + ((size_t)(b * NKV + hl) * SEQ + t) * HD;
                        if (rp) {
                            const f32x4 cs = *(const f32x4*)(rope + (size_t)t * 64 + j4), sn = *(const f32x4*)(rope + (size_t)t * 64 + 32 + j4);
                            f32x4 o1 = v0 * cs - v1 * sn, o2 = v1 * cs + v0 * sn;
                            if (isq) { o1 = o1 * QSCALE; o2 = o2 * QSCALE; }
                            u32x2 w1, w2; w1.x = cvt_pk_bf16(o1[0], o1[1]); w1.y = cvt_pk_bf16(o1[2], o1[3]); w2.x = cvt_pk_bf16(o2[0], o2[1]); w2.y = cvt_pk_bf16(o2[2], o2[3]);
                            *(u32x2*)(dst + j4) = w1; *(u32x2*)(dst + 32 + j4) = w2;
                        } else {
                            u32x4 w; w.x = cvt_pk_bf16(v0[0], v0[1]); w.y = cvt_pk_bf16(v0[2], v0[3]); w.z = cvt_pk_bf16(v1[0], v1[1]); w.w = cvt_pk_bf16(v1[2], v1[3]);
                            *(u32x4*)(dst + (c0 & 63)) = w;
                        }
                    }
                }
            }
    }
};
struct EpiResid {
    static constexpr bool PERM = false;
    float* Y; const bf16_t* R;
    __device__ __forceinline__ void operator()(const f32x4 (&acc)[2][2][4][2], const Unit& u, int wr, int wc, int fr, int fq) const {
        const int row0 = u.pm * BM + wr * 64 + fr, col0 = u.pn * BM + wc * 32 + 4 * fq;
#pragma unroll
        for (int ai = 0; ai < 2; ++ai)
#pragma unroll
            for (int m = 0; m < 4; ++m) { const size_t off = (size_t)(row0 + ai * HALF + m * 16) * DM + col0;
#pragma unroll
                for (int bj = 0; bj < 2; ++bj)
#pragma unroll
                    for (int n = 0; n < 2; ++n) { const u32x2 rw = *(const u32x2*)(R + off + bj * HALF + n * 16);
                        f32x4 o = acc[ai][bj][m][n]; o[0] += DN_ALPHA * bf_lo(rw.x); o[1] += DN_ALPHA * bf_hi(rw.x); o[2] += DN_ALPHA * bf_lo(rw.y); o[3] += DN_ALPHA * bf_hi(rw.y);
                        *(f32x4*)(Y + off + bj * HALF + n * 16) = o; } }
    }
};
struct EpiSwiglu {
    static constexpr bool PERM = true;
    bf16_t* H; int ldh; int row_sub;
    __device__ __forceinline__ void operator()(const f32x4 (&acc)[2][2][4][2], const Unit& u, int wr, int wc, int fr, int fq) const {
        const int row0 = u.pm * BM - row_sub + wr * 64 + fr, col0 = u.pn * HALF + wc * 32 + 8 * fq;
#pragma unroll
        for (int ai = 0; ai < 2; ++ai)
#pragma unroll
            for (int m = 0; m < 4; ++m) { bf16_t* rowp = H + (size_t)(row0 + ai * HALF + m * 16) * ldh + col0; float o[8];
#pragma unroll
                for (int n = 0; n < 2; ++n)
#pragma unroll
                    for (int k = 0; k < 4; ++k) { const float gv = acc[ai][0][m][n][k], uv = acc[ai][1][m][n][k];
                        o[4 * n + k] = gv * __builtin_amdgcn_rcpf(1.f + __builtin_amdgcn_exp2f(-gv * LOG2E)) * uv; }
                u32x4 w; w.x = cvt_pk_bf16(o[0], o[1]); w.y = cvt_pk_bf16(o[2], o[3]); w.z = cvt_pk_bf16(o[4], o[5]); w.w = cvt_pk_bf16(o[6], o[7]);
                *(u32x4*)rowp = w; }
    }
};
template <int ACT> struct EpiBf16 {
    static constexpr bool PERM = true;
    bf16_t* O; int ldc; const float* bias;
    __device__ __forceinline__ void operator()(const f32x4 (&acc)[2][2][4][2], const Unit& u, int wr, int wc, int fr, int fq) const {
        const int row0 = u.pm * BM + wr * 64 + fr, col0 = u.pn * BM + wc * 32 + 8 * fq;
#pragma unroll
        for (int ai = 0; ai < 2; ++ai)
#pragma unroll
            for (int m = 0; m < 4; ++m) { bf16_t* rowp = O + (size_t)(row0 + ai * HALF + m * 16) * ldc + col0;
#pragma unroll
                for (int bj = 0; bj < 2; ++bj) { f32x4 v0 = acc[ai][bj][m][0], v1 = acc[ai][bj][m][1];
                    if (ACT == 1) { const f32x4 b0 = *(const f32x4*)(bias + col0 + bj * HALF), b1 = *(const f32x4*)(bias + col0 + bj * HALF + 4); v0 = v0 + b0; v1 = v1 + b1;
#pragma unroll
                        for (int k = 0; k < 4; ++k) {
                            { const float x = v0[k], z = 1.5957691216057308f * (x + 0.044715f * x * x * x); v0[k] = x * __builtin_amdgcn_rcpf(1.f + __builtin_amdgcn_exp2f(-z * LOG2E)); }
                            { const float x = v1[k], z = 1.5957691216057308f * (x + 0.044715f * x * x * x); v1[k] = x * __builtin_amdgcn_rcpf(1.f + __builtin_amdgcn_exp2f(-z * LOG2E)); } } }
                    u32x4 w; w.x = cvt_pk_bf16(v0[0], v0[1]); w.y = cvt_pk_bf16(v0[2], v0[3]); w.z = cvt_pk_bf16(v1[0], v1[1]); w.w = cvt_pk_bf16(v1[2], v1[3]);
                    *(u32x4*)(rowp + bj * HALF) = w; } }
    }
};
}

constexpr size_t MiB = 1u << 20;
constexpr size_t WS_CTL = 0, CTL_ZERO_BYTES = 64 * 1024;
constexpr size_t WS_ROPE = 1 * MiB;
constexpr size_t WS_ROUTE = 2 * MiB;
constexpr size_t WS_KCC = 3 * MiB, WS_VCC = 4 * MiB;
constexpr size_t WS_MISC = 5 * MiB;
constexpr size_t WS_GATES = 6 * MiB;
constexpr size_t WS_WA_IN = 16 * MiB, WS_WA_OUT = 19 * MiB, WS_WB_IN = 21 * MiB, WS_WB_OUT = 27 * MiB, WS_CW1K = 29 * MiB, WS_CW1V = 30 * MiB;
constexpr size_t WS_FFN_GU = 31 * MiB, WS_FFN_D = 45 * MiB, WS_MOE_GU = 52 * MiB, WS_MOE_D = 164 * MiB;
constexpr size_t WS_ACT = 220 * MiB;
constexpr size_t WS_XB = WS_ACT;
constexpr size_t WS_Q = WS_ACT + 64 * MiB;
constexpr size_t WS_KV = WS_ACT + 128 * MiB;
constexpr size_t KV_STRIDE_B = 16 * MiB;
constexpr size_t WS_HFF = WS_ACT;
constexpr size_t WS_X1B = WS_ACT + 224 * MiB;
constexpr size_t WS_CHID = WS_ACT + 224 * MiB;
constexpr size_t WS_X3B = WS_ACT;
constexpr size_t WS_XG = WS_ACT + 64 * MiB;
constexpr size_t WS_HMOE = WS_ACT + 196 * MiB;
constexpr size_t WS_END = WS_ACT + 308 * MiB;
static_assert(WS_MOE_D + 8 * 7 * MiB <= WS_ACT && WS_X1B + 64 * MiB <= WS_END && WS_HMOE + 112 * MiB <= WS_END && WS_XG + 132 * MiB <= WS_HMOE, "d_ws map");
constexpr int CW_CNT = 64;
constexpr int CW_BAR = 1024;

constexpr int RING_BYTES = 131072, LDSCTL_OFF = 135168, LDS_BYTES = 147456;

#define XB_TMO      128
#define XB_XCNT(j)  (256  + 64 * (j))
#define XB_XSUB(j)  (1280 + 64 * (j))
#define XB_XGEN(j)  (2304 + 64 * (j))
#define XB_TOP      3328
#define XB_TOPGEN   3392
#define XCD_BAR_WORDS 3456
#define XB_SPIN_CAP (1u << 18)
static_assert((CW_BAR + XCD_BAR_WORDS) * 4 <= (int)CTL_ZERO_BYTES, "CTL words inside the memset region");
__device__ __forceinline__ unsigned xb_ld(unsigned* p)              { return __hip_atomic_load(p, __ATOMIC_RELAXED, __HIP_MEMORY_SCOPE_AGENT); }
__device__ __forceinline__ unsigned xb_add(unsigned* p, unsigned v) { return __hip_atomic_fetch_add(p, v, __ATOMIC_RELAXED, __HIP_MEMORY_SCOPE_AGENT); }
__device__ __forceinline__ unsigned xb_xcc_id() { return (unsigned)__builtin_amdgcn_s_getreg((3 << 11) | 20) & 0xFu; }
#define XB_SPIN(cond, bar) do { unsigned _sp = 0; while (cond) { __builtin_amdgcn_s_sleep(1); \
    if ((++_sp & 255u) == 0u) { if (xb_ld(&(bar)[XB_TMO])) break; if (_sp > XB_SPIN_CAP) { atomicAdd(&(bar)[XB_TMO], 1u); break; } } } } while (0)
struct XcdBarrier { unsigned* bar; unsigned x; volatile LAS unsigned* st; };
__device__ __forceinline__ XcdBarrier xcd_barrier_post(unsigned* bar, volatile LAS unsigned* st) {
    XcdBarrier b; b.bar = bar; b.x = xb_xcc_id(); b.st = st;
    if (threadIdx.x == 0) (void)xb_add(&bar[XB_XCNT(b.x)], 1u);
    return b;
}
__device__ __forceinline__ void xcd_barrier_complete(unsigned* bar, unsigned x, unsigned& nloc, unsigned& nx) {
    const unsigned G = gridDim.x * gridDim.y * gridDim.z;
    unsigned sum, cnt, mine, sp = 0u;
    for (;;) {
        sum = 0u; cnt = 0u; mine = 0u;
#pragma unroll
        for (unsigned j = 0; j < 16; ++j) { const unsigned c = xb_ld(&bar[XB_XCNT(j)]); sum += c; cnt += (c > 0u) ? 1u : 0u; mine = (j == x) ? c : mine; }
        if (sum == G) break;
        __builtin_amdgcn_s_sleep(1);
        if ((++sp & 255u) == 0u) { if (xb_ld(&bar[XB_TMO])) break; if (sp > XB_SPIN_CAP) { atomicAdd(&bar[XB_TMO], 1u); break; } }
    }
    nloc = mine > 0u ? mine : 1u; nx = cnt > 0u ? cnt : 1u;
}
__device__ __forceinline__ void xcd_barrier(const XcdBarrier& b) {
    asm volatile("s_waitcnt vmcnt(0)" ::: "memory");
    __syncthreads();
    if (threadIdx.x == 0) {
        unsigned* bar = b.bar;
        __builtin_amdgcn_s_waitcnt(0);
        unsigned nloc = b.st[0], nx = b.st[1];
        if (nloc == 0u) { xcd_barrier_complete(bar, b.x, nloc, nx); b.st[0] = nloc; b.st[1] = nx; }
        const unsigned old = xb_add(&bar[XB_XSUB(b.x)], 1u);
        const unsigned gen = old / nloc;
        if (old + 1u == (gen + 1u) * nloc) {
            __builtin_amdgcn_fence(__ATOMIC_RELEASE, "agent");
            asm volatile("s_waitcnt vmcnt(0)" ::: "memory");
            const unsigned og = xb_add(&bar[XB_TOP], 1u);
            const unsigned tg = og / nx;
            if (og + 1u == (tg + 1u) * nx) xb_add(&bar[XB_TOPGEN], 1u);
            else XB_SPIN(xb_ld(&bar[XB_TOPGEN]) == tg, bar);
            __builtin_amdgcn_fence(__ATOMIC_ACQUIRE, "agent");
            xb_add(&bar[XB_XGEN(b.x)], 1u);
            asm volatile("s_waitcnt vmcnt(0)" ::: "memory");
        } else {
            XB_SPIN(xb_ld(&bar[XB_XGEN(b.x)]) == gen, bar);
            __builtin_amdgcn_fence(__ATOMIC_ACQUIRE, "agent");
            asm volatile("s_waitcnt vmcnt(0)" ::: "memory");
        }
    }
    __syncthreads();
}

__device__ __forceinline__ float wave_sum(float v) {
#pragma unroll
    for (int o = 1; o < 64; o <<= 1) v += __shfl_xor(v, o);
    return v;
}
__device__ __forceinline__ unsigned f2bf(float f) { unsigned u = __float_as_uint(f); return (u + 0x7fffu + ((u >> 16) & 1u)) >> 16; }
__device__ __forceinline__ unsigned pk2(float lo, float hi) { return f2bf(lo) | (f2bf(hi) << 16); }
#define LDS_WAIT() asm volatile("s_waitcnt lgkmcnt(0)" ::: "memory")

__device__ __forceinline__ int wmap(int mode, int n) {
    if (mode == 1) { const int h = n & ~63, d = n & 63; return h + (d < 32 ? 8 * (d >> 2) + (d & 3) : 8 * ((d - 32) >> 2) + 4 + (d & 3)); }
    if (mode == 2) return ((n >> 7) << 8) + (n & 127);
    if (mode == 3) return ((n >> 7) << 8) + 128 + (n & 127);
    return n;
}
__device__ __forceinline__ void transpose_item(const float* W, int K, int N, bf16_t* WT, int row_off, int mode, LAS float* scr, int item, int lane) {
    const int nblk = (N + 31) / 32, kb = item / nblk, nb = item % nblk, k0 = 64 * kb, n0 = 32 * nb;
    const int nn = n0 + (lane & 31); const bool nok = nn < N;
#pragma unroll 8
    for (int i = 0; i < 32; ++i) { const int kk = 2 * i + (lane >> 5); scr[kk * 33 + (lane & 31)] = nok ? W[(size_t)(k0 + kk) * N + nn] : 0.f; }
    LDS_WAIT(); asm volatile("" ::: "memory");
    const int c = lane & 7;
#pragma unroll
    for (int j = 0; j < 4; ++j) { const int n = (lane >> 3) + 8 * j; const LAS float* s = scr + (8 * c) * 33 + n;
        u32x4 o; o.x = pk2(s[0 * 33], s[1 * 33]); o.y = pk2(s[2 * 33], s[3 * 33]); o.z = pk2(s[4 * 33], s[5 * 33]); o.w = pk2(s[6 * 33], s[7 * 33]);
        if (n0 + n < N) *(u32x4*)(WT + (size_t)(row_off + wmap(mode, n0 + n)) * K + k0 + 8 * c) = o; }
    LDS_WAIT(); asm volatile("" ::: "memory");
}

namespace att {
constexpr float NEG_INF = -__builtin_huge_valf();
struct St { float m, l; f32x16 o0, o1; };
__device__ __forceinline__ void st_init(St& s, float m0, float l0) { s.m = m0; s.l = l0;
#pragma unroll
    for (int r = 0; r < 16; ++r) { s.o0[r] = 0.f; s.o1[r] = 0.f; } }
__device__ __forceinline__ float xhalf(float v) { return __shfl_xor(v, 32); }
__device__ __forceinline__ void kv_fetch(const bf16_t* Kg, const bf16_t* Vg, int wid, int lane, u32x4& kreg, u32x4& vreg) {
    kreg = *(const u32x4*)(Kg + lane * 64 + wid * 8);
    vreg = *(const u32x4*)(Vg + (16 * (wid & 3) + (lane >> 2)) * 64 + (wid >> 2) * 32 + (lane & 3) * 8);
}
__device__ __forceinline__ void kv_store(LAS unsigned char* Ks, LAS unsigned char* Vs, int wid, int lane, const u32x4& kreg, const u32x4& vreg) {
    *(LAS u32x4*)(Ks + wid * 1024 + lane * 16) = kreg; *(LAS u32x4*)(Vs + wid * 1024 + lane * 16) = vreg;
}
__device__ __forceinline__ s16x4 vtr(const LAS unsigned char* p) { typedef short v4i16_t __attribute__((ext_vector_type(4)));
    return __builtin_bit_cast(s16x4, __builtin_amdgcn_ds_read_tr16_b64_v4i16((LAS v4i16_t*)p)); }
__device__ __forceinline__ void qkt(f32x16& p0, f32x16& p1, const LAS unsigned char* Ks, const bf16x8 (&qr)[4], int lane) {
    const LAS unsigned char* kp = Ks + (lane >> 5) * 1024 + (lane & 31) * 16;
#pragma unroll
    for (int r = 0; r < 16; ++r) { p0[r] = 0.f; p1[r] = 0.f; }
#pragma unroll
    for (int d0 = 0; d0 < 4; ++d0) {
        const bf16x8 b0 = *(const LAS bf16x8*)(kp + d0 * 2048), b1 = *(const LAS bf16x8*)(kp + d0 * 2048 + 512);
        p0 = __builtin_amdgcn_mfma_f32_32x32x16_bf16(b0, qr[d0], p0, 0, 0, 0);
        p1 = __builtin_amdgcn_mfma_f32_32x32x16_bf16(b1, qr[d0], p1, 0, 0, 0);
    }
}
__device__ __forceinline__ void kmask(f32x16& p0, f32x16& p1, int lo_c, int hi_c, int lane) {
    const int base = 4 * (lane >> 5) - lo_c; const unsigned span = (unsigned)(hi_c - lo_c);
#pragma unroll
    for (int r = 0; r < 16; ++r) { const int kv = (r & 3) + 8 * (r >> 2);
        if ((unsigned)(kv + base) > span) p0[r] = NEG_INF;
        if ((unsigned)(kv + 32 + base) > span) p1[r] = NEG_INF; }
}
__device__ __forceinline__ void pv(f32x16& o0, f32x16& o1, const f32x16& p0, const f32x16& p1, const LAS unsigned char* Vs, int lane) {
    const LAS unsigned char* vp = Vs + ((lane >> 4) & 1) * 32 + (lane & 3) * 8 + (4 * (lane >> 5) + ((lane & 15) >> 2)) * 64;
    u32x4 pw[4];
#pragma unroll
    for (int i = 0; i < 4; ++i) { pw[0][i] = cvt_pk_bf16(p0[2 * i], p0[2 * i + 1]); pw[1][i] = cvt_pk_bf16(p0[8 + 2 * i], p0[9 + 2 * i]);
                                  pw[2][i] = cvt_pk_bf16(p1[2 * i], p1[2 * i + 1]); pw[3][i] = cvt_pk_bf16(p1[8 + 2 * i], p1[9 + 2 * i]); }
#pragma unroll
    for (int s = 0; s < 4; ++s) {
        const s16x4 l0 = vtr(vp + s * 1024), h0 = vtr(vp + s * 1024 + 512), l1 = vtr(vp + 4096 + s * 1024), h1 = vtr(vp + 4096 + s * 1024 + 512);
        const bf16x8 v0 = (bf16x8){l0[0], l0[1], l0[2], l0[3], h0[0], h0[1], h0[2], h0[3]}, v1 = (bf16x8){l1[0], l1[1], l1[2], l1[3], h1[0], h1[1], h1[2], h1[3]};
        const bf16x8 pa = __builtin_bit_cast(bf16x8, pw[s]);
        o0 = __builtin_amdgcn_mfma_f32_32x32x16_bf16(v0, pa, o0, 0, 0, 0);
        o1 = __builtin_amdgcn_mfma_f32_32x32x16_bf16(v1, pa, o1, 0, 0, 0);
    }
}
__device__ __forceinline__ float rowmax(const f32x16& p0, const f32x16& p1) {
    float a = fmaxf(p0[0], p1[0]);
#pragma unroll
    for (int r = 1; r < 16; ++r) a = fmaxf(a, fmaxf(p0[r], p1[r]));
    return fmaxf(a, xhalf(a));
}
template <bool MASK, bool PV>
__device__ __forceinline__ void block(const LAS unsigned char* Ks, const LAS unsigned char* Vs, const bf16x8 (&qr)[4], St& st, int lo_c, int hi_c, bool lane_on, int lane) {
    f32x16 p0, p1; qkt(p0, p1, Ks, qr, lane);
    if (MASK) kmask(p0, p1, lo_c, hi_c, lane);
    float rm = rowmax(p0, p1); rm = lane_on ? rm : NEG_INF;
    const float mn = fmaxf(st.m, rm), alpha = __builtin_amdgcn_exp2f(st.m - mn), mu = lane_on ? mn : -NEG_INF;
    float sum = 0.f;
#pragma unroll
    for (int r = 0; r < 16; ++r) { p0[r] = __builtin_amdgcn_exp2f(p0[r] - mu); p1[r] = __builtin_amdgcn_exp2f(p1[r] - mu); sum += p0[r] + p1[r]; }
    st.l = st.l * alpha + sum; st.m = mn;
    if (PV) {
#pragma unroll
        for (int r = 0; r < 16; ++r) { st.o0[r] *= alpha; st.o1[r] *= alpha; }
        pv(st.o0, st.o1, p0, p1, Vs, lane);
    }
}
template <bool PV>
__device__ __forceinline__ void block_any(const LAS unsigned char* Ks, const LAS unsigned char* Vs, const bf16x8 (&qr)[4], St& st, int lo_rel, int hi_rel, bool extra_on, int lane) {
    const bool on = extra_on && hi_rel >= 0 && lo_rel <= 63;
    if (!__any(on)) return;
    const int lo_c = lo_rel < 0 ? 0 : lo_rel, hi_c = hi_rel > 63 ? 63 : hi_rel;
    if (__any(on && (lo_c > 0 || hi_c < 63))) block<true, PV>(Ks, Vs, qr, st, lo_c, hi_c, on, lane);
    else block<false, PV>(Ks, Vs, qr, st, 0, 63, on, lane);
}
__device__ __forceinline__ void load_q(bf16x8 (&qr)[4], const bf16_t* Qrow  , int lane) {
#pragma unroll
    for (int d0 = 0; d0 < 4; ++d0) qr[d0] = *(const bf16x8*)(Qrow + d0 * 16 + (lane >> 5) * 8);
}
__device__ __forceinline__ void fold(f32x16& a0, f32x16& a1, const St& st, float w) {
    const float lt = st.l + xhalf(st.l), sc = lt > 0.f ? w / lt : 0.f;
#pragma unroll
    for (int r = 0; r < 16; ++r) { a0[r] += sc * st.o0[r]; a1[r] += sc * st.o1[r]; }
}
__device__ __forceinline__ void store_o(bf16_t* Orow, const f32x16& a0, const f32x16& a1, int lane) {
    const int hi = lane >> 5;
#pragma unroll
    for (int r = 0; r < 16; r += 2) { const int d = (r & 3) + 8 * (r >> 2) + 4 * hi;
        *(unsigned*)(Orow + d) = cvt_pk_bf16(a0[r], a0[r + 1]); *(unsigned*)(Orow + 32 + d) = cvt_pk_bf16(a1[r], a1[r + 1]); }
}
}

__device__ __forceinline__ void swa_unit(LAS unsigned char* lds, int b, int kvh, int tile, const bf16_t* Q, const bf16_t* Kh, const bf16_t* Vh, bf16_t* O, const float* sinks) {
    int tid = threadIdx.x; asm volatile("" : "+v"(tid));
    const int lane = tid & 63, wid = __builtin_amdgcn_readfirstlane(tid >> 6), g = wid & 3, s = wid >> 2, r32 = lane & 31;
    const bf16_t* Kb = Kh + (size_t)(b * NKV + kvh) * SEQ * HD; const bf16_t* Vb = Vh + (size_t)(b * NKV + kvh) * SEQ * HD;
    u32x4 kr[3], vr[3];
#pragma unroll
    for (int i = 0; i < 3; ++i) { const int j = tile - 2 + i; if (j >= 0) att::kv_fetch(Kb + (size_t)j * 64 * HD, Vb + (size_t)j * 64 * HD, wid, lane, kr[i], vr[i]); }
    const int t = tile * 64 + s * 32 + r32, head = kvh * 4 + g;
    const size_t qoff = ((size_t)b * SEQ + t) * DM + head * HD;
    bf16x8 qr[4]; att::load_q(qr, Q + qoff, lane);
#pragma unroll
    for (int i = 0; i < 3; ++i) { const int j = tile - 2 + i; if (j >= 0) att::kv_store(lds + i * 8192, lds + 24576 + i * 8192, wid, lane, kr[i], vr[i]); }
    __syncthreads();
    att::St st; att::st_init(st, sinks[head] * LOG2E, (lane < 32) ? 1.f : 0.f);
#pragma unroll
    for (int i = 0; i < 3; ++i) { const int j = tile - 2 + i;
        if (j >= 0) att::block_any<true>(lds + i * 8192, lds + 24576 + i * 8192, qr, st, t - 127 - 64 * j, t - 64 * j, true, lane); }
    f32x16 a0, a1;
#pragma unroll
    for (int r = 0; r < 16; ++r) { a0[r] = 0.f; a1[r] = 0.f; }
    att::fold(a0, a1, st, 1.f);
    att::store_o(O + qoff, a0, a1, lane);
    __syncthreads();
}

static_assert(65536 + 4 * 64 * 65 * 4 <= LDSCTL_OFF, "NSA importance table below the LDS control words");
constexpr int NSA_IMP = 65536, NSA_IMPF = 0, NSA_SELM = 16640, NSA_SELU = 17152, NSA_KS = 32768, NSA_VS = 49152;
struct NsaT { const bf16_t* Q; bf16_t* O; const bf16_t *KS, *VS, *KW, *VW, *KCC, *VCC; const float* gates; };
__device__ __forceinline__ void nsa_unit(LAS unsigned char* lds, int b, int kvh, int tile, const NsaT& T) {
    int tid = threadIdx.x; asm volatile("" : "+v"(tid));
    const int lane = tid & 63, wid = __builtin_amdgcn_readfirstlane(tid >> 6), g = wid & 3, s = wid >> 2, r32 = lane & 31, hi = lane >> 5;
    const int t = tile * 64 + s * 32 + r32, head = kvh * 4 + g, cur = tile;
    const size_t qoff = ((size_t)b * SEQ + t) * DM + head * HD;
    const size_t bh = (size_t)(b * NKV + kvh);
    {
        const bf16_t* Kc = T.KCC + bh * 256 * HD; const bf16_t* Vc = T.VCC + bh * 256 * HD; u32x4 kr[4], vr[4];
#pragma unroll
        for (int i = 0; i < 4; ++i) att::kv_fetch(Kc + i * 64 * HD, Vc + i * 64 * HD, wid, lane, kr[i], vr[i]);
#pragma unroll
        for (int i = 0; i < 4; ++i) att::kv_store(lds + i * 8192, lds + 32768 + i * 8192, wid, lane, kr[i], vr[i]);
    }
    bf16x8 qr[4]; att::load_q(qr, T.Q + qoff, lane);
    const float* gp = T.gates + ((size_t)b * SEQ + t) * 48 + head * 3;
    const float g_c = gp[0], g_s = gp[1], g_w = gp[2];
    __syncthreads();
    f32x16 a0, a1;
#pragma unroll
    for (int r = 0; r < 16; ++r) { a0[r] = 0.f; a1[r] = 0.f; }
    const int iv = (t - 31) >> 4;
    {
        att::St st; att::st_init(st, -1e30f, 0.f);
#pragma unroll 1
        for (int blk = 0; blk < 4; ++blk) att::block_any<false>(lds + blk * 8192, lds + 32768 + blk * 8192, qr, st, 0, iv - 64 * blk, true, lane);
        const float lt = st.l + att::xhalf(st.l), inv_l = lt > 0.f ? 1.f / lt : 0.f, mfin = st.m;
        f32x16 c0, c1;
#pragma unroll
        for (int r = 0; r < 16; ++r) { c0[r] = 0.f; c1[r] = 0.f; }
        int r32o = r32; asm volatile("" : "+v"(r32o));
        LAS float* imp_row = (LAS float*)(lds + NSA_IMP) + (g * 64 + s * 32 + r32o) * 65;
        float prevx = 0.f;
#pragma unroll 1
        for (int blk = 0; blk < 4; ++blk) {
            const int hi_rel = iv - 64 * blk; const bool on = hi_rel >= 0;
            if (!__any(on)) {
#pragma unroll
                for (int k = 0; k < 8; ++k) imp_row[16 * blk + 2 * k + hi] = 0.f;
                prevx = 0.f; continue;
            }
            f32x16 p0, p1; att::qkt(p0, p1, lds + blk * 8192, qr, lane);
            att::kmask(p0, p1, 0, hi_rel > 63 ? 63 : hi_rel, lane);
            const float mu = on ? mfin : -att::NEG_INF;
#pragma unroll
            for (int r = 0; r < 16; ++r) { p0[r] = __builtin_amdgcn_exp2f(p0[r] - mu) * inv_l; p1[r] = __builtin_amdgcn_exp2f(p1[r] - mu) * inv_l; }
#pragma unroll
            for (int tt = 0; tt < 2; ++tt)
#pragma unroll
                for (int r2 = 0; r2 < 4; ++r2) {
                    const float pa = tt ? p1[4 * r2] : p0[4 * r2], pb = tt ? p1[4 * r2 + 1] : p0[4 * r2 + 1], pc = tt ? p1[4 * r2 + 2] : p0[4 * r2 + 2], pd = tt ? p1[4 * r2 + 3] : p0[4 * r2 + 3];
                    float own = 2.f * (pa + pb + pc) + pd; const float other = att::xhalf(pd);
                    if (hi) own += other; else { own += prevx; prevx = other; }
                    imp_row[16 * blk + 8 * tt + 2 * r2 + hi] = own;
                }
            att::pv(c0, c1, p0, p1, lds + 32768 + blk * 8192, lane);
        }
#pragma unroll
        for (int r = 0; r < 16; ++r) { a0[r] = g_c * c0[r]; a1[r] = g_c * c1[r]; }
    }
    __syncthreads();
    {
        int tid2 = tid; asm volatile("" : "+v"(tid2));
        const int tok = tid2 >> 3, seg = tid2 & 7; const LAS float* ip = (const LAS float*)(lds + NSA_IMP); LAS float* impf = (LAS float*)(lds + NSA_IMPF);
        float v[8];
#pragma unroll
        for (int i = 0; i < 8; ++i) { const int j = 8 * seg + i;
            float x = (ip[(0 * 64 + tok) * 65 + j] + ip[(1 * 64 + tok) * 65 + j]) + (ip[(2 * 64 + tok) * 65 + j] + ip[(3 * 64 + tok) * 65 + j]);
            if (j == 0 || j == cur || j == cur - 1) x = 1e4f;
            if (j > cur) x = -1.f;
            v[i] = x; }
        if (tid < 2) ((LAS unsigned*)(lds + NSA_SELU))[tid] = 0u;
#pragma unroll
        for (int i = 0; i < 8; ++i) impf[tok * 65 + 8 * seg + i] = v[i];
        __syncthreads();
        int rank[8];
#pragma unroll
        for (int i = 0; i < 8; ++i) rank[i] = 0;
        for (int k = 0; k < 64; ++k) { const float x = impf[tok * 65 + k];
#pragma unroll
            for (int i = 0; i < 8; ++i) rank[i] += (x > v[i] || (x == v[i] && k < 8 * seg + i)) ? 1 : 0; }
        unsigned bits = 0;
#pragma unroll
        for (int i = 0; i < 8; ++i) bits |= (rank[i] < 16 ? 1u : 0u) << i;
        unsigned mlo = seg < 4 ? bits << (8 * seg) : 0u, mhi = seg >= 4 ? bits << (8 * (seg - 4)) : 0u;
#pragma unroll
        for (int o = 1; o < 8; o <<= 1) { mlo |= __shfl_xor(mlo, o); mhi |= __shfl_xor(mhi, o); }
        if (seg == 0) { LAS unsigned* sm = (LAS unsigned*)(lds + NSA_SELM); sm[2 * tok] = mlo; sm[2 * tok + 1] = mhi; }
        unsigned ulo = mlo, uhi = mhi;
#pragma unroll
        for (int o = 8; o < 64; o <<= 1) { ulo |= __shfl_xor(ulo, o); uhi |= __shfl_xor(uhi, o); }
        if (lane == 0) { __hip_atomic_fetch_or((LAS unsigned*)(lds + NSA_SELU), ulo, __ATOMIC_RELAXED, __HIP_MEMORY_SCOPE_WORKGROUP); __hip_atomic_fetch_or((LAS unsigned*)(lds + NSA_SELU) + 1, uhi, __ATOMIC_RELAXED, __HIP_MEMORY_SCOPE_WORKGROUP); }
        __syncthreads();
    }
    {
        const LAS unsigned* sm = (const LAS unsigned*)(lds + NSA_SELM);
        int r32o = r32; asm volatile("" : "+v"(r32o));
        const unsigned mlo = sm[2 * (s * 32 + r32o)], mhi = sm[2 * (s * 32 + r32o) + 1];
        const unsigned ulo = __builtin_amdgcn_readfirstlane(((const LAS unsigned*)(lds + NSA_SELU))[0]), uhi = __builtin_amdgcn_readfirstlane(((const LAS unsigned*)(lds + NSA_SELU))[1]);
        unsigned long long U = ((unsigned long long)uhi << 32) | ulo;
        if (cur < 63) U &= (1ull << (cur + 1)) - 1ull;
        const bf16_t* Kb = T.KS + bh * SEQ * HD; const bf16_t* Vb = T.VS + bh * SEQ * HD;
        att::St st; att::st_init(st, -1e30f, 0.f);
        int j = __builtin_ctzll(U | (1ull << 63)), slot = 0; u32x4 kr, vr;
        att::kv_fetch(Kb + (size_t)j * 64 * HD, Vb + (size_t)j * 64 * HD, wid, lane, kr, vr);
        att::kv_store(lds + NSA_KS, lds + NSA_VS, wid, lane, kr, vr);
        __syncthreads();
        for (;;) {
            const unsigned long long rest = (j >= 63) ? 0ull : (U & ~((2ull << j) - 1ull));
            const bool has_next = rest != 0ull; const int jn = has_next ? __builtin_ctzll(rest) : j;
            if (has_next) att::kv_fetch(Kb + (size_t)jn * 64 * HD, Vb + (size_t)jn * 64 * HD, wid, lane, kr, vr);
            const bool sel = ((j < 32 ? (mlo >> j) : (mhi >> (j - 32))) & 1u) != 0u;
            att::block_any<true>(lds + NSA_KS + slot * 8192, lds + NSA_VS + slot * 8192, qr, st, 0, t - 64 * j, sel, lane);
            if (has_next) att::kv_store(lds + NSA_KS + (slot ^ 1) * 8192, lds + NSA_VS + (slot ^ 1) * 8192, wid, lane, kr, vr);
            __syncthreads();
            if (!has_next) break;
            j = jn; slot ^= 1;
        }
        att::fold(a0, a1, st, g_s);
    }
    {
        const bf16_t* Kb = T.KW + bh * SEQ * HD; const bf16_t* Vb = T.VW + bh * SEQ * HD;
        att::St st; att::st_init(st, -1e30f, 0.f);
        int j = cur - 8 < 0 ? 0 : cur - 8, slot = 0; u32x4 kr, vr;
        att::kv_fetch(Kb + (size_t)j * 64 * HD, Vb + (size_t)j * 64 * HD, wid, lane, kr, vr);
        att::kv_store(lds + NSA_KS, lds + NSA_VS, wid, lane, kr, vr);
        __syncthreads();
        for (;;) {
            const bool has_next = j < cur;
            if (has_next) att::kv_fetch(Kb + (size_t)(j + 1) * 64 * HD, Vb + (size_t)(j + 1) * 64 * HD, wid, lane, kr, vr);
            att::block_any<true>(lds + NSA_KS + slot * 8192, lds + NSA_VS + slot * 8192, qr, st, t - 511 - 64 * j, t - 64 * j, true, lane);
            if (has_next) att::kv_store(lds + NSA_KS + (slot ^ 1) * 8192, lds + NSA_VS + (slot ^ 1) * 8192, wid, lane, kr, vr);
            __syncthreads();
            if (!has_next) break;
            ++j; slot ^= 1;
        }
        att::fold(a0, a1, st, g_w);
    }
    att::store_o(T.O + qoff, a0, a1, lane);
}

__device__ __forceinline__ void ln_apply(f32x4 (&v)[4], const float* gain, const float* bias, int lane) {
    float s = 0.f;
#pragma unroll
    for (int j = 0; j < 4; ++j) s += (v[j][0] + v[j][1]) + (v[j][2] + v[j][3]);
    const float mean = wave_sum(s) * (1.f / DM); float s2 = 0.f;
#pragma unroll
    for (int j = 0; j < 4; ++j) { v[j] = v[j] - mean; s2 += (v[j][0] * v[j][0] + v[j][1] * v[j][1]) + (v[j][2] * v[j][2] + v[j][3] * v[j][3]); }
    const float rstd = 1.f / sqrtf(wave_sum(s2) * (1.f / DM) + LN_EPS);
#pragma unroll
    for (int j = 0; j < 4; ++j) { const f32x4 gg = *(const f32x4*)(gain + 4 * lane + 256 * j), bb = *(const f32x4*)(bias + 4 * lane + 256 * j); v[j] = v[j] * rstd * gg + bb; }
}
__device__ __forceinline__ void store_row_bf16(bf16_t* orow, const f32x4 (&v)[4], int lane) {
#pragma unroll
    for (int j = 0; j < 4; ++j) { u32x2 w; w.x = cvt_pk_bf16(v[j][0], v[j][1]); w.y = cvt_pk_bf16(v[j][2], v[j][3]); *(u32x2*)(orow + 4 * lane + 256 * j) = w; }
}
__device__ __forceinline__ void load_row_bf16(f32x4 (&v)[4], const bf16_t* row, int lane) {
#pragma unroll
    for (int j = 0; j < 4; ++j) { const u32x2 w = *(const u32x2*)(row + 4 * lane + 256 * j); v[j][0] = bf_lo(w.x); v[j][1] = bf_hi(w.x); v[j][2] = bf_lo(w.y); v[j][3] = bf_hi(w.y); }
}
__device__ __forceinline__ void moe_offsets(unsigned* ctl, int (&toff)[9]) {
    int acc = 0;
#pragma unroll
    for (int e = 0; e < 8; ++e) { toff[e] = acc; const int c = (int)__builtin_amdgcn_readfirstlane(__hip_atomic_load(ctl + CW_CNT + 64 * e, __ATOMIC_RELAXED, __HIP_MEMORY_SCOPE_AGENT)); acc += (c + 255) >> 8; }
    toff[8] = acc;
}
struct BOffMoe { int t1, t2, t3, t4, t5, t6, t7; size_t estride, tstride;
    __device__ __forceinline__ size_t operator()(const pg8::Unit& u) const {
        const int pm = u.pm; const int e = (pm >= t1) + (pm >= t2) + (pm >= t3) + (pm >= t4) + (pm >= t5) + (pm >= t6) + (pm >= t7);
        return (size_t)e * estride + (size_t)u.pn * tstride; } };
struct BOffCmp { __device__ __forceinline__ size_t operator()(const pg8::Unit& u) const { return (u.pm >= 32) ? (size_t)MiB : (size_t)0; } };
struct EpiCmp {
    static constexpr bool PERM = true;
    bf16_t* O; const float* bias;
    __device__ __forceinline__ void operator()(const f32x4 (&acc)[2][2][4][2], const pg8::Unit& u, int wr, int wc, int fr, int fq) const {
        pg8::EpiBf16<1> e{O, 256, bias + ((u.pm >= 32) ? 256 : 0)}; e(acc, u, wr, wc, fr, fq);
    }
};

__device__ const double ROPE_INV[32] = {1.0, 0.7498942093324559, 0.5623413251903491, 0.4216965034285822, 0.31622776601683794, 0.23713737056616552, 0.1778279410038923, 0.1333521432163324,
    0.1, 0.07498942093324558, 0.05623413251903491, 0.042169650342858224, 0.03162277660168379, 0.023713737056616554, 0.01778279410038923, 0.01333521432163324,
    0.01, 0.007498942093324558, 0.005623413251903491, 0.004216965034285823, 0.0031622776601683794, 0.0023713737056616554, 0.0017782794100389228, 0.001333521432163324,
    0.001, 0.0007498942093324559, 0.0005623413251903491, 0.00042169650342858224, 0.00031622776601683794, 0.00023713737056616554, 0.00017782794100389227, 0.0001333521432163324};

constexpr int NPH = 26;
struct Args { const float* in[21]; float* out; unsigned char* ws; int ph_lo, ph_hi; };
enum { I_X = 0, I_AWIN, I_AWOUT, I_ASINK, I_BWIN, I_BWOUT, I_POSK, I_POSV, I_CKW1, I_CKW2, I_CVW1, I_CVW2, I_FG, I_FU, I_FD, I_ROUTER, I_MG, I_MU, I_MD, I_LNG, I_LNB };

__global__ void __launch_bounds__(512, 2) fwd(Args args) {
    extern __shared__ __attribute__((aligned(16))) unsigned char lds_raw[];
    LAS unsigned char* lds = (LAS unsigned char*)lds_raw;
    const int tid = threadIdx.x, lane = tid & 63, wave = __builtin_amdgcn_readfirstlane(tid >> 6);
    const int G = gridDim.x, wg = blockIdx.x, gw = wg * 8 + wave, NGW = G * 8;
    unsigned char* ws = args.ws;
    unsigned* ctl = (unsigned*)(ws + WS_CTL);
    const int lo = args.ph_lo, hi = args.ph_hi;
    volatile LAS unsigned* MISC = (volatile LAS unsigned*)(lds + LDSCTL_OFF);
    if (tid < 64) MISC[tid] = 0u;
    __syncthreads();
    XcdBarrier bar; bar.bar = ctl + CW_BAR; bar.x = 0; bar.st = MISC + 8;
    if (hi - lo > 1) bar = xcd_barrier_post(ctl + CW_BAR, MISC + 8);
#ifndef PHMASK
#define PHMASK 0xFFFFFFFFu
#endif
#define IN(k) (((PHMASK >> (k)) & 1u) && lo <= (k) && (k) < hi)
#define SEAM(k) do { if (IN(k) && IN((k) + 1)) xcd_barrier(bar); } while (0)
    bf16_t* const WA_IN = (bf16_t*)(ws + WS_WA_IN); bf16_t* const WA_OUT = (bf16_t*)(ws + WS_WA_OUT); bf16_t* const WB_IN = (bf16_t*)(ws + WS_WB_IN); bf16_t* const WB_OUT = (bf16_t*)(ws + WS_WB_OUT);
    bf16_t* const CW1 = (bf16_t*)(ws + WS_CW1K); bf16_t* const FFN_GU = (bf16_t*)(ws + WS_FFN_GU); bf16_t* const FFN_D = (bf16_t*)(ws + WS_FFN_D);
    bf16_t* const MOE_GU = (bf16_t*)(ws + WS_MOE_GU); bf16_t* const MOE_D = (bf16_t*)(ws + WS_MOE_D);
    float* const ROPE = (float*)(ws + WS_ROPE); float* const POSB = (float*)(ws + WS_MISC); bf16_t* const W2T = (bf16_t*)(ws + WS_MISC + 4096);
    float* const GATES = (float*)(ws + WS_GATES); bf16_t* const KCC = (bf16_t*)(ws + WS_KCC);
    bf16_t* const XB = (bf16_t*)(ws + WS_XB); bf16_t* const QB = (bf16_t*)(ws + WS_Q); bf16_t* const KVB = (bf16_t*)(ws + WS_KV);
    bf16_t* const HFF = (bf16_t*)(ws + WS_HFF); bf16_t* const X1B = (bf16_t*)(ws + WS_X1B); bf16_t* const CHID = (bf16_t*)(ws + WS_CHID);
    bf16_t* const X3B = (bf16_t*)(ws + WS_X3B); bf16_t* const XG = (bf16_t*)(ws + WS_XG); bf16_t* const HMOE = (bf16_t*)(ws + WS_HMOE);
    int* const ROUTE = (int*)(ws + WS_ROUTE);
    constexpr size_t KVS = KV_STRIDE_B / 2;

    if (IN(0)) {
        LAS float* scr = (LAS float*)(lds + wave * 16384);
        constexpr int I_A1 = 16 * 48, I_A2 = 16 * 32, I_B1 = 16 * 82, I_B2 = 16 * 32, I_C1 = 32 * 8, I_C2 = 4 * 2, I_F = 16 * 112, I_FDN = 56 * 32, I_ME = 2 * I_F + I_FDN;
        constexpr int NITEMS = I_A1 + I_A2 + I_B1 + I_B2 + 2 * I_C1 + 2 * I_C2 + 2 * I_F + I_FDN + 8 * I_ME;
        for (int it = gw; it < NITEMS; it += NGW) {
            int r = it;
            if (r < I_A1) { const int n0 = 32 * (r % 48); transpose_item(args.in[I_AWIN], 1024, 1536, WA_IN, 0, n0 < 1280 ? 1 : 0, scr, r, lane); continue; } r -= I_A1;
            if (r < I_A2) { transpose_item(args.in[I_AWOUT], 1024, 1024, WA_OUT, 0, 0, scr, r, lane); continue; } r -= I_A2;
            if (r < I_B1) { const int n0 = 32 * (r % 82); const bool rp = n0 < 1280 || (n0 >= 1536 && n0 < 1792) || (n0 >= 2048 && n0 < 2304);
                transpose_item(args.in[I_BWIN], 1024, NSA_IN, WB_IN, 0, rp ? 1 : 0, scr, r, lane); continue; } r -= I_B1;
            if (r < I_B2) { transpose_item(args.in[I_BWOUT], 1024, 1024, WB_OUT, 0, 0, scr, r, lane); continue; } r -= I_B2;
            if (r < I_C1) { transpose_item(args.in[I_CKW1], 2048, 256, CW1, 0, 0, scr, r, lane); continue; } r -= I_C1;
            if (r < I_C1) { transpose_item(args.in[I_CVW1], 2048, 256, CW1, 256, 0, scr, r, lane); continue; } r -= I_C1;
            if (r < I_C2) { transpose_item(args.in[I_CKW2], 256, 64, W2T, 0, 0, scr, r, lane); continue; } r -= I_C2;
            if (r < I_C2) { transpose_item(args.in[I_CVW2], 256, 64, W2T, 64, 0, scr, r, lane); continue; } r -= I_C2;
            if (r < I_F) { transpose_item(args.in[I_FG], 1024, DFF, FFN_GU, 0, 2, scr, r, lane); continue; } r -= I_F;
            if (r < I_F) { transpose_item(args.in[I_FU], 1024, DFF, FFN_GU, 0, 3, scr, r, lane); continue; } r -= I_F;
            if (r < I_FDN) { transpose_item(args.in[I_FD], DFF, 1024, FFN_D, 0, 0, scr, r, lane); continue; } r -= I_FDN;
            const int e = r / I_ME; r -= e * I_ME;
            if (r < I_F) { transpose_item(args.in[I_MG] + (size_t)e * 1024 * DFF, 1024, DFF, MOE_GU + (size_t)e * 2 * DFF * 1024, 0, 2, scr, r, lane); continue; } r -= I_F;
            if (r < I_F) { transpose_item(args.in[I_MU] + (size_t)e * 1024 * DFF, 1024, DFF, MOE_GU + (size_t)e * 2 * DFF * 1024, 0, 3, scr, r, lane); continue; } r -= I_F;
            transpose_item(args.in[I_MD] + (size_t)e * DFF * 1024, DFF, 1024, MOE_D + (size_t)e * 1024 * DFF, 0, 0, scr, r, lane);
        }
        for (int m = gw; m < TTOK; m += NGW) {
            f32x4 v[4];
#pragma unroll
            for (int j = 0; j < 4; ++j) v[j] = *(const f32x4*)(args.in[I_X] + (size_t)m * DM + 4 * lane + 256 * j);
            store_row_bf16(XB + (size_t)m * DM, v, lane);
        }
        for (int i = wg * 512 + tid; i < SEQ * 32; i += G * 512) {
            const int t = i >> 5, f = i & 31; const double rev = (double)t * ROPE_INV[f] * 0.15915494309189535; const float fr = (float)(rev - __builtin_rint(rev));
            ROPE[t * 64 + f] = __builtin_amdgcn_cosf(fr); ROPE[t * 64 + 32 + f] = __builtin_amdgcn_sinf(fr);
        }
        for (int o = gw; o < 512; o += NGW) {
            const float* pos = args.in[o < 256 ? I_POSK : I_POSV]; const float* w1 = args.in[o < 256 ? I_CKW1 : I_CVW1]; const int n = o & 255; float s = 0.f;
            for (int k = lane; k < 2048; k += 64) s += pos[k] * w1[(size_t)k * 256 + n];
            s = wave_sum(s); if (lane == 0) POSB[o] = s;
        }
        for (int i = wg * 512 + tid; i < (NSA_IN_PAD - NSA_IN) * 1024 / 8; i += G * 512) *(u32x4*)(WB_IN + (size_t)NSA_IN * 1024 + (size_t)i * 8) = (u32x4){0u, 0u, 0u, 0u};
    }
    SEAM(0);
    if (IN(1)) {
        pg8::Gemm g{XB, WA_IN, 1024, 1024}; pg8::StaticOrder S; S.init(128, 6, G, wg, 0);
        pg8::EpiProj E{QB, KVB, KVS, nullptr, ROPE, 1, -1};
        pg8::gemm_phase(lds, g, S, E, pg8::BOffPlain{1024});
    }
    SEAM(1);
    if (IN(2)) {
        for (int u = wg; u < 2048; u += G) { const int bk = u & 31; swa_unit(lds, bk >> 2, bk & 3, u >> 5, QB, KVB, KVB + KVS, QB, args.in[I_ASINK]); }
    }
    SEAM(2);
    if (IN(3)) {
        pg8::Gemm g{QB, WA_OUT, 1024, 1024}; pg8::StaticOrder S; S.init(128, 4, G, wg, 0);
        pg8::EpiResid E{args.out, XB};
        pg8::gemm_phase(lds, g, S, E, pg8::BOffPlain{1024});
    }
    SEAM(3);
    if (IN(4)) {
        for (int m = gw; m < TTOK; m += NGW) { f32x4 v[4];
#pragma unroll
            for (int j = 0; j < 4; ++j) v[j] = *(const f32x4*)(args.out + (size_t)m * DM + 4 * lane + 256 * j);
            ln_apply(v, args.in[I_LNG], args.in[I_LNB], lane); store_row_bf16(X1B + (size_t)m * DM, v, lane); }
    }
    SEAM(4);
    if (IN(5)) {
        pg8::Gemm g{X1B, FFN_GU, 1024, 1024}; pg8::StaticOrder S; S.init(128, 28, G, wg, 0);
        pg8::EpiSwiglu E{HFF, DFF, 0};
        pg8::gemm_phase(lds, g, S, E, pg8::BOffPlain{1024});
    }
    SEAM(5);
    if (IN(6)) {
        pg8::Gemm g{HFF, FFN_D, DFF, DFF}; pg8::StaticOrder S; S.init(128, 4, G, wg, 0);
        pg8::EpiResid E{args.out, X1B};
        pg8::gemm_phase(lds, g, S, E, pg8::BOffPlain{DFF});
    }
    SEAM(6);
    if (IN(7)) {
        for (int m = gw; m < TTOK; m += NGW) { f32x4 v[4];
#pragma unroll
            for (int j = 0; j < 4; ++j) v[j] = *(const f32x4*)(args.out + (size_t)m * DM + 4 * lane + 256 * j);
            ln_apply(v, args.in[I_LNG] + 1024, args.in[I_LNB] + 1024, lane); store_row_bf16(XB + (size_t)m * DM, v, lane); }
    }
    SEAM(7);
    if (IN(8)) {
        pg8::Gemm g{XB, WB_IN, 1024, 1024}; pg8::StaticOrder S; S.init(128, 11, G, wg, 0);
        pg8::EpiProj E{QB, KVB, KVS, GATES, ROPE, 0x15, 10};
        pg8::gemm_phase(lds, g, S, E, pg8::BOffPlain{1024});
    }
    SEAM(8);
    if (IN(9)) {
        pg8::Gemm g{KVB, CW1, 1024, 2048}; pg8::StaticOrder S; S.init(64, 1, G, wg, 0);
        EpiCmp E{CHID, POSB};
        pg8::gemm_phase(lds, g, S, E, BOffCmp{});
    }
    SEAM(9);
    if (IN(10)) {
        const int r32 = lane & 31, hh = lane >> 5;
        for (int task = gw; task < 512; task += NGW) {
            const int row0 = task * 32, which = row0 >> 13; const bf16_t* Hrow = CHID + (size_t)(row0 + r32) * 256; const bf16_t* Wt = W2T + which * 64 * 256;
            f32x16 c0, c1;
#pragma unroll
            for (int r = 0; r < 16; ++r) { c0[r] = 0.f; c1[r] = 0.f; }
#pragma unroll
            for (int ks = 0; ks < 16; ++ks) { const bf16x8 a = *(const bf16x8*)(Hrow + ks * 16 + hh * 8), b0 = *(const bf16x8*)(Wt + r32 * 256 + ks * 16 + hh * 8), b1 = *(const bf16x8*)(Wt + (32 + r32) * 256 + ks * 16 + hh * 8);
                c0 = __builtin_amdgcn_mfma_f32_32x32x16_bf16(a, b0, c0, 0, 0, 0); c1 = __builtin_amdgcn_mfma_f32_32x32x16_bf16(a, b1, c1, 0, 0, 0); }
#pragma unroll
            for (int r = 0; r < 16; ++r) { const int grow = row0 + (r & 3) + 8 * (r >> 2) + 4 * hh; const bool z = (grow & 255) == 255;
                KCC[(size_t)grow * 64 + r32] = (bf16_t)f2bf(z ? 0.f : c0[r]); KCC[(size_t)grow * 64 + 32 + r32] = (bf16_t)f2bf(z ? 0.f : c1[r]); }
        }
    }
    SEAM(10);
    if (IN(11)) {
        const NsaT T{QB, QB, KVB + 2 * KVS, KVB + 3 * KVS, KVB + 4 * KVS, KVB + 5 * KVS, KCC, KCC + (size_t)8192 * 64, GATES};
        for (int u = wg; u < 2048; u += G) { const int bk = u & 31, rr = u >> 5, rnd = rr >> 3, q = rr & 7;
            const int tile = 63 - (8 * rnd + ((rnd & 1) ? 7 - q : q)); nsa_unit(lds, bk >> 2, bk & 3, tile, T); }
    }
    SEAM(11);
    if (IN(12)) {
        pg8::Gemm g{QB, WB_OUT, 1024, 1024}; pg8::StaticOrder S; S.init(128, 4, G, wg, 0);
        pg8::EpiResid E{args.out, XB};
        pg8::gemm_phase(lds, g, S, E, pg8::BOffPlain{1024});
    }
    SEAM(12);
    if (IN(13)) {
        f32x4 rw[16][2];
#pragma unroll
        for (int j = 0; j < 4; ++j)
#pragma unroll
            for (int k = 0; k < 4; ++k) { const float* rp = args.in[I_ROUTER] + (size_t)(4 * lane + 256 * j + k) * 8; rw[4 * j + k][0] = *(const f32x4*)rp; rw[4 * j + k][1] = *(const f32x4*)(rp + 4); }
        LAS int* cntl = (LAS int*)lds;
        for (int u = wg; u < TTOK / 128; u += G) {
            int c[8];
#pragma unroll
            for (int e = 0; e < 8; ++e) c[e] = 0;
            int me1 = 0, me2 = 0, ms1 = 0, ms2 = 0; float mw1 = 0.f, mw2 = 0.f;
            for (int i = 0; i < 16; ++i) {
                const int m = u * 128 + wave * 16 + i; f32x4 v[4];
#pragma unroll
                for (int j = 0; j < 4; ++j) v[j] = *(const f32x4*)(args.out + (size_t)m * DM + 4 * lane + 256 * j);
                ln_apply(v, args.in[I_LNG] + 2048, args.in[I_LNB] + 2048, lane); store_row_bf16(X3B + (size_t)m * DM, v, lane);
                float lg[8];
#pragma unroll
                for (int e = 0; e < 8; ++e) lg[e] = 0.f;
#pragma unroll
                for (int j = 0; j < 4; ++j)
#pragma unroll
                    for (int k = 0; k < 4; ++k) { const float x = v[j][k];
#pragma unroll
                        for (int e = 0; e < 4; ++e) { lg[e] += x * rw[4 * j + k][0][e]; lg[4 + e] += x * rw[4 * j + k][1][e]; } }
#pragma unroll
                for (int e = 0; e < 8; ++e) lg[e] = wave_sum(lg[e]);
                int e1 = 0; float v1 = lg[0];
#pragma unroll
                for (int e = 1; e < 8; ++e) if (lg[e] > v1) { v1 = lg[e]; e1 = e; }
                int e2 = -1; float v2 = 0.f;
#pragma unroll
                for (int e = 0; e < 8; ++e) if (e != e1 && (e2 < 0 || lg[e] > v2)) { v2 = lg[e]; e2 = e; }
                const float ex = __expf(v2 - v1), w1 = 1.f / (1.f + ex), w2 = ex * w1;
                int s1 = 0, s2 = 0;
#pragma unroll
                for (int e = 0; e < 8; ++e) { if (e == e1) s1 = c[e]; if (e == e2) s2 = c[e]; c[e] += (e == e1 || e == e2) ? 1 : 0; }
                if (lane == i) { me1 = e1; me2 = e2; ms1 = s1; ms2 = s2; mw1 = w1; mw2 = w2; }
            }
            __syncthreads();
            if (lane < 8) { int cv = 0;
#pragma unroll
                for (int e = 0; e < 8; ++e) if (lane == e) cv = c[e];
                cntl[wave * 8 + lane] = cv; }
            __syncthreads();
            if (tid < 8) { int tot = 0;
#pragma unroll
                for (int w = 0; w < 8; ++w) tot += cntl[w * 8 + tid];
                int base = (int)__hip_atomic_fetch_add(ctl + CW_CNT + 64 * tid, (unsigned)tot, __ATOMIC_RELAXED, __HIP_MEMORY_SCOPE_AGENT);
#pragma unroll
                for (int w = 0; w < 8; ++w) { cntl[64 + w * 8 + tid] = base; base += cntl[w * 8 + tid]; } }
            __syncthreads();
            if (lane < 16) { int* rp = ROUTE + (size_t)(u * 128 + wave * 16 + lane) * 8;
                rp[0] = me1; rp[1] = me2; rp[2] = cntl[64 + wave * 8 + me1] + ms1; rp[3] = cntl[64 + wave * 8 + me2] + ms2; ((float*)rp)[4] = mw1; ((float*)rp)[5] = mw2; }
        }
    }
    SEAM(13);
    if (IN(14)) {
        int toff[9]; moe_offsets(ctl, toff);
        for (int m = gw; m < TTOK; m += NGW) {
            const int* rp = ROUTE + (size_t)m * 8; const int e1 = __builtin_amdgcn_readfirstlane(rp[0]), e2 = __builtin_amdgcn_readfirstlane(rp[1]), s1 = __builtin_amdgcn_readfirstlane(rp[2]), s2 = __builtin_amdgcn_readfirstlane(rp[3]);
            int t1 = 0, t2 = 0;
#pragma unroll
            for (int e = 0; e < 8; ++e) { if (e == e1) t1 = toff[e]; if (e == e2) t2 = toff[e]; }
            const u32x4 a = *(const u32x4*)(X3B + (size_t)m * DM + lane * 8), b = *(const u32x4*)(X3B + (size_t)m * DM + 512 + lane * 8);
            bf16_t* d1 = XG + ((size_t)t1 * 256 + s1) * DM; bf16_t* d2 = XG + ((size_t)t2 * 256 + s2) * DM;
            *(u32x4*)(d1 + lane * 8) = a; *(u32x4*)(d1 + 512 + lane * 8) = b; *(u32x4*)(d2 + lane * 8) = a; *(u32x4*)(d2 + 512 + lane * 8) = b;
        }
    }
    SEAM(14);
    for (int c = 0; c < 5; ++c) {
        if (IN(15 + 2 * c)) {
            int toff[9]; moe_offsets(ctl, toff); const int nt = toff[8] - 64 * c; const int ntc = nt < 0 ? 0 : (nt > 64 ? 64 : nt);
            pg8::Gemm g{XG, MOE_GU, 1024, 1024}; pg8::StaticOrder S; S.init(ntc, 28, G, wg, 64 * c);
            pg8::EpiSwiglu E{HMOE, DFF, 64 * c * 256};
            pg8::gemm_phase(lds, g, S, E, BOffMoe{toff[1], toff[2], toff[3], toff[4], toff[5], toff[6], toff[7], (size_t)2 * DFF * 1024 * 2, (size_t)256 * 1024 * 2});
        }
        SEAM(15 + 2 * c);
        if (IN(16 + 2 * c)) {
            int toff[9]; moe_offsets(ctl, toff); const int nt = toff[8] - 64 * c; const int ntc = nt < 0 ? 0 : (nt > 64 ? 64 : nt);
            pg8::Gemm g{HMOE - (size_t)64 * c * 256 * DFF, MOE_D, DFF, DFF}; pg8::StaticOrder S; S.init(ntc, 4, G, wg, 64 * c);
            pg8::EpiBf16<0> E{XG, 1024, nullptr};
            pg8::gemm_phase(lds, g, S, E, BOffMoe{toff[1], toff[2], toff[3], toff[4], toff[5], toff[6], toff[7], (size_t)1024 * DFF * 2, (size_t)256 * DFF * 2});
        }
        SEAM(16 + 2 * c);
    }
    if (IN(25)) {
        int toff[9]; moe_offsets(ctl, toff);
        for (int m = gw; m < TTOK; m += NGW) {
            const int* rp = ROUTE + (size_t)m * 8; const int e1 = __builtin_amdgcn_readfirstlane(rp[0]), e2 = __builtin_amdgcn_readfirstlane(rp[1]), s1 = __builtin_amdgcn_readfirstlane(rp[2]), s2 = __builtin_amdgcn_readfirstlane(rp[3]);
            const float w1 = __uint_as_float(__builtin_amdgcn_readfirstlane(rp[4])), w2 = __uint_as_float(__builtin_amdgcn_readfirstlane(rp[5]));
            int t1 = 0, t2 = 0;
#pragma unroll
            for (int e = 0; e < 8; ++e) { if (e == e1) t1 = toff[e]; if (e == e2) t2 = toff[e]; }
            f32x4 x[4], y1[4], y2[4];
            load_row_bf16(x, X3B + (size_t)m * DM, lane); load_row_bf16(y1, XG + ((size_t)t1 * 256 + s1) * DM, lane); load_row_bf16(y2, XG + ((size_t)t2 * 256 + s2) * DM, lane);
#pragma unroll
            for (int j = 0; j < 4; ++j) x[j] = x[j] * DN_ALPHA + (y1[j] * w1 + y2[j] * w2);
            ln_apply(x, args.in[I_LNG] + 3072, args.in[I_LNB] + 3072, lane);
#pragma unroll
            for (int j = 0; j < 4; ++j) *(f32x4*)(args.out + (size_t)m * DM + 4 * lane + 256 * j) = x[j];
        }
    }
#undef IN
#undef SEAM
}

#ifndef MK_PER_PHASE
#define MK_PER_PHASE 1
#endif
extern "C" void kernel_launch(void* const* d_in, const int* in_sizes, int n_in, void* d_out, int out_size, void* d_ws, size_t ws_size, hipStream_t stream) {
    static int grid = 0;
    if (grid == 0) {
        if (n_in != 21 || in_sizes[0] != TTOK * DM || out_size != TTOK * DM || ws_size < WS_END) { fprintf(stderr, "kernel_launch: unexpected shapes (n_in %d, ws %zu < %zu?)\n", n_in, ws_size, (size_t)WS_END); grid = -1; return; }
        int dev = 0, cus = 0;
        if (hipGetDevice(&dev) != hipSuccess || hipDeviceGetAttribute(&cus, hipDeviceAttributeMultiprocessorCount, dev) != hipSuccess) { grid = -1; return; }
        if (hipFuncSetAttribute((const void*)fwd, hipFuncAttributeMaxDynamicSharedMemorySize, LDS_BYTES) != hipSuccess) { fprintf(stderr, "kernel_launch: hipFuncSetAttribute failed\n"); grid = -1; return; }
        int per_cu = 0;
        if (hipOccupancyMaxActiveBlocksPerMultiprocessor(&per_cu, (const void*)fwd, 512, LDS_BYTES) != hipSuccess || per_cu < 1) { fprintf(stderr, "kernel_launch: occupancy query says %d\n", per_cu); }
        (void)hipGetLastError();
        grid = cus;
    }
    if (grid < 0) return;
    (void)hipMemsetAsync((char*)d_ws + WS_CTL, 0, CTL_ZERO_BYTES, stream);
    Args a{};
    for (int i = 0; i < 21; ++i) a.in[i] = (const float*)d_in[i];
    a.out = (float*)d_out; a.ws = (unsigned char*)d_ws;
#if MK_PER_PHASE
    for (int p = 0; p < NPH; ++p) { a.ph_lo = p; a.ph_hi = p + 1; hipLaunchKernelGGL(fwd, dim3(grid), dim3(512), LDS_BYTES, stream, a); }
#else
    a.ph_lo = 0; a.ph_hi = NPH; hipLaunchKernelGGL(fwd, dim3(grid), dim3(512), LDS_BYTES, stream, a);
#endif
}
```

```cpp
#include <hip/hip_runtime.h>
#include <cstdio>
#include <cstdint>
#include <cmath>

#define LAS __attribute__((address_space(3)))
#define GAS __attribute__((address_space(1)))

typedef unsigned short bf16_t;
typedef short bf16x8 __attribute__((ext_vector_type(8)));
typedef short s16x4 __attribute__((ext_vector_type(4)));
typedef float f32x4 __attribute__((ext_vector_type(4)));
typedef float f32x2 __attribute__((ext_vector_type(2)));
typedef float f32x16 __attribute__((ext_vector_type(16)));
typedef unsigned u32x4 __attribute__((ext_vector_type(4)));
typedef unsigned u32x2 __attribute__((ext_vector_type(2)));

constexpr int NB = 8, SEQ = 4096, TTOK = NB * SEQ, DM = 1024, DFF = 3584, NEXP = 8, HD = 64, NKV = 4;
constexpr float DN_ALPHA = 1.4142135623730951f;
constexpr float LN_EPS = 1e-5f;
constexpr float QSCALE = 0.125f * 1.4426950408889634f;
constexpr float LOG2E = 1.4426950408889634f;
constexpr int NSA_IN = 2608, NSA_IN_PAD = 2816;

__device__ __forceinline__ unsigned cvt_pk_bf16(float lo, float hi) { unsigned r; asm volatile("v_cvt_pk_bf16_f32 %0, %1, %2" : "=v"(r) : "v"(lo), "v"(hi)); return r; }
__device__ __forceinline__ float bf_lo(unsigned w) { return __uint_as_float(w << 16); }
__device__ __forceinline__ float bf_hi(unsigned w) { return __uint_as_float(w & 0xffff0000u); }

namespace pg8 {
constexpr int BM = 256, BK = 64, HALF = 128, HTB = HALF * BK * 2, STAGE_BYTES = 8 * HTB, NXCD = 8, WGM = 8;
__host__ __device__ __forceinline__ int lds_byte(int r, int c) { const int st = (r >> 4) * 2 + (c >> 5), rr = r & 15, cc = c & 31, ob = rr * 64 + cc * 2; return st * 1024 + (ob ^ (((ob >> 9) & 1) << 5)); }
__host__ __device__ __forceinline__ void stage_rc(int b, int& R, int& C) { const int st = b / 1024, sb = b % 1024, swz = sb ^ (((sb >> 9) & 1) << 5); R = (st >> 1) * 16 + swz / 64; C = (st & 1) * 32 + (swz % 64) / 2; }
__host__ __device__ __forceinline__ int perm32(int rho) { const int n = rho >> 4, i = rho & 15; return 8 * (i >> 2) + 4 * n + (i & 3); }

struct Unit { int pm, pn; };
struct Gemm { const bf16_t* A; const bf16_t* Bt; int lda; int K; };

struct StaticOrder {
    int nM, nN, nwg, G, c, pm0;
    __device__ void init(int nM_, int nN_, int G_, int c_, int pm0_) { nM = nM_; nN = nN_; nwg = nM * nN; G = G_; c = c_; pm0 = pm0_; }
    __device__ bool next(int i, Unit& u) const {
        const long L = (long)i * G + c; if (L >= nwg) return false;
        int wgid = (int)L; { const int q = nwg / NXCD, r = nwg % NXCD, xcd = wgid % NXCD, off = wgid / NXCD; wgid = (xcd < r ? xcd * (q + 1) : r * (q + 1) + (xcd - r) * q) + off; }
        const int nig = WGM * nN, gid = wgid / nig, fm = gid * WGM, gsz = (nM - fm) < WGM ? (nM - fm) : WGM;
        u.pm = pm0 + fm + ((wgid % nig) % gsz); u.pn = (wgid % nig) / gsz; return true;
    }
};

template <class Epi, class Sched, class BOff>
__device__ __forceinline__ void gemm_phase(LAS unsigned char* lds, const Gemm g, const Sched& S, const Epi& E, const BOff& boff) {
    const int tid = threadIdx.x, wid = __builtin_amdgcn_readfirstlane(tid >> 6), lane = tid & 63, wr = wid >> 2, wc = wid & 3, fr = lane & 15, fq = lane >> 4;
    const int K = g.K, nt = K / BK;
    unsigned voffA[2], voffB[2];
#pragma unroll
    for (int i = 0; i < 2; ++i) { int R, C; stage_rc(tid * 16 + i * 8192, R, C); const int Rb = Epi::PERM ? ((R & ~31) + perm32(R & 31)) : R;
        voffA[i] = (unsigned)(R * g.lda + C) * 2u; voffB[i] = (unsigned)(Rb * K + C) * 2u; }
    const size_t kstep = (size_t)(BK * 2);
    const size_t hstepA = (size_t)HALF * g.lda * 2, hstepB = (size_t)HALF * K * 2;
    const size_t tstepA = 2 * hstepA;
    const unsigned ldsw = (unsigned)wid * 1024u;
    const int aoff = lds_byte(wr * 64 + fr, fq * 8), boffl = lds_byte(wc * 32 + fr, fq * 8);
#define PG8_SA(b, h) (((b) * 2 + (h)) * HTB)
#define PG8_SB(b, h) ((4 + (b) * 2 + (h)) * HTB)
#define PG8_STAGE(bufoff, gbase, voff) do { _Pragma("unroll") for (int _i = 0; _i < 2; ++_i) \
        __builtin_amdgcn_global_load_lds((const unsigned*)((const char*)(gbase) + (voff)[_i]), (LAS unsigned*)(lds + (bufoff) + ldsw + _i * 8192), 16, 0, 0); } while (0)
#define PG8_LDA(dst, b, h) do { _Pragma("unroll") for (int m = 0; m < 4; ++m) _Pragma("unroll") for (int k = 0; k < 2; ++k) dst[m][k] = *(const LAS bf16x8*)(lds + PG8_SA(b, h) + aoff + m * 2048 + k * 1024); } while (0)
#define PG8_LDB(dst, b, h) do { _Pragma("unroll") for (int n = 0; n < 2; ++n) _Pragma("unroll") for (int k = 0; k < 2; ++k) dst[n][k] = *(const LAS bf16x8*)(lds + PG8_SB(b, h) + boffl + n * 2048 + k * 1024); } while (0)
#define PG8_MMA(ai, bj, At, Bt) do { __builtin_amdgcn_s_setprio(1); _Pragma("unroll") for (int m = 0; m < 4; ++m) _Pragma("unroll") for (int n = 0; n < 2; ++n) _Pragma("unroll") for (int k = 0; k < 2; ++k) \
        acc[ai][bj][m][n] = __builtin_amdgcn_mfma_f32_16x16x32_bf16(Bt[n][k], At[m][k], acc[ai][bj][m][n], 0, 0, 0); __builtin_amdgcn_s_setprio(0); } while (0)
#define PG8_WAIT_V(n) asm volatile("s_waitcnt vmcnt(" #n ")" ::: "memory")
#define PG8_WAIT_L(n) asm volatile("s_waitcnt lgkmcnt(" #n ")" ::: "memory")
#define PG8_BAR __builtin_amdgcn_s_barrier()
#define PG8_SCHED __builtin_amdgcn_sched_barrier(0)
    Unit cur, nxt; int ui = 0;
    if (!S.next(0, cur)) return;
    f32x4 acc[2][2][4][2];
#pragma unroll
    for (int a = 0; a < 2; ++a)
#pragma unroll
        for (int b = 0; b < 2; ++b)
#pragma unroll
            for (int m = 0; m < 4; ++m)
#pragma unroll
                for (int n = 0; n < 2; ++n) acc[a][b][m][n] = (f32x4){0.f, 0.f, 0.f, 0.f};
    bf16x8 At[4][2], B0[2][2], B1[2][2];
    const char* cA = (const char*)g.A + (size_t)cur.pm * tstepA; const char* cB = (const char*)g.Bt + boff(cur);
    PG8_STAGE(PG8_SB(0, 0), cB, voffB); PG8_STAGE(PG8_SB(0, 1), cB + hstepB, voffB); PG8_STAGE(PG8_SA(0, 0), cA, voffA); PG8_STAGE(PG8_SA(0, 1), cA + hstepA, voffA);
    if (wr == 1) PG8_BAR;
    PG8_WAIT_V(2); PG8_BAR;
    PG8_STAGE(PG8_SB(1, 0), cB + kstep, voffB); PG8_STAGE(PG8_SA(1, 0), cA + kstep, voffA); PG8_STAGE(PG8_SB(1, 1), cB + hstepB + kstep, voffB);
    PG8_WAIT_V(6); PG8_BAR;
    for (;;) {
        const bool has_next = S.next(ui + 1, nxt);
        const char* nA = has_next ? (const char*)g.A + (size_t)nxt.pm * tstepA : cA; const char* nB = has_next ? (const char*)g.Bt + boff(nxt) : cB;
        for (int t = 0; t < nt; t += 2) {
            const bool last = (t == nt - 2);
            const char* a1 = cA + (size_t)(t + 1) * kstep;
            const char* a2 = last ? nA : cA + (size_t)(t + 2) * kstep; const char* b2 = last ? nB : cB + (size_t)(t + 2) * kstep;
            const char* a3 = a2 + kstep; const char* b3 = b2 + kstep;
            PG8_LDB(B0, 0, 0); PG8_LDB(B1, 0, 1); PG8_SCHED; PG8_LDA(At, 0, 0); PG8_STAGE(PG8_SA(1, 1), a1 + hstepA, voffA);
            PG8_WAIT_V(8); PG8_WAIT_L(0); PG8_BAR; PG8_MMA(0, 0, At, B0); PG8_MMA(0, 1, At, B1); PG8_BAR; PG8_SCHED;
            PG8_LDA(At, 0, 1); PG8_STAGE(PG8_SB(0, 0), b2, voffB); PG8_STAGE(PG8_SB(0, 1), b2 + hstepB, voffB); PG8_STAGE(PG8_SA(0, 0), a2, voffA);
            PG8_WAIT_V(8); PG8_WAIT_L(0); PG8_BAR; PG8_MMA(1, 0, At, B0); PG8_MMA(1, 1, At, B1); PG8_BAR; PG8_SCHED;
            PG8_LDB(B0, 1, 0); PG8_LDB(B1, 1, 1); PG8_SCHED; PG8_LDA(At, 1, 0); PG8_STAGE(PG8_SA(0, 1), a2 + hstepA, voffA);
            PG8_WAIT_V(8); PG8_WAIT_L(0); PG8_BAR; PG8_MMA(0, 0, At, B0); PG8_MMA(0, 1, At, B1); PG8_BAR; PG8_SCHED;
            PG8_LDA(At, 1, 1); PG8_STAGE(PG8_SB(1, 0), b3, voffB); PG8_STAGE(PG8_SB(1, 1), b3 + hstepB, voffB); PG8_STAGE(PG8_SA(1, 0), a3, voffA);
            PG8_WAIT_V(8); PG8_WAIT_L(0); PG8_BAR; PG8_MMA(1, 0, At, B0); PG8_MMA(1, 1, At, B1); PG8_BAR; PG8_SCHED;
        }
        if (wr == 0) PG8_BAR;
        E(acc, cur, wr, wc, fr, fq);
        if (!has_next) break;
#pragma unroll
        for (int a = 0; a < 2; ++a)
#pragma unroll
            for (int b = 0; b < 2; ++b)
#pragma unroll
                for (int m = 0; m < 4; ++m)
#pragma unroll
                    for (int n = 0; n < 2; ++n) acc[a][b][m][n] = (f32x4){0.f, 0.f, 0.f, 0.f};
        cur = nxt; cA = nA; cB = nB; ++ui;
        if (wr == 1) PG8_BAR;
    }
    PG8_WAIT_V(0);
    PG8_BAR;
#undef PG8_SA
#undef PG8_SB
#undef PG8_STAGE
#undef PG8_LDA
#undef PG8_LDB
#undef PG8_MMA
#undef PG8_WAIT_V
#undef PG8_WAIT_L
#undef PG8_BAR
#undef PG8_SCHED
}
struct BOffPlain { int K; __device__ __forceinline__ size_t operator()(const Unit& u) const { return (size_t)u.pn * 256 * K * 2; } };

struct EpiProj {
    static constexpr bool PERM = true;
    bf16_t* Q; bf16_t* KV; size_t kvstride; float* gates; const float* rope; int ropemask; int gate_tile;
    __device__ __forceinline__ void operator()(const f32x4 (&acc)[2][2][4][2], const Unit& u, int wr, int wc, int fr, int fq) const {
        const int pn = u.pn;
#pragma unroll
        for (int ai = 0; ai < 2; ++ai)
#pragma unroll
            for (int m = 0; m < 4; ++m) {
                const int row = u.pm * BM + ai * HALF + wr * 64 + m * 16 + fr, t = row & (SEQ - 1), b = row >> 12;
#pragma unroll
                for (int bj = 0; bj < 2; ++bj) {
                    const int c0 = bj * HALF + wc * 32 + 8 * fq, hl = c0 >> 6, j4 = (c0 & 63) >> 1;
                    f32x4 v0 = acc[ai][bj][m][0], v1 = acc[ai][bj][m][1];
                    if (pn == gate_tile) {
                        if (c0 < 48) { float* gp = gates + (size_t)row * 48 + c0; f32x4 s0, s1;
#pragma unroll
                            for (int k = 0; k < 4; ++k) { s0[k] = __builtin_amdgcn_rcpf(1.f + __builtin_amdgcn_exp2f(-v0[k] * LOG2E)); s1[k] = __builtin_amdgcn_rcpf(1.f + __builtin_amdgcn_exp2f(-v1[k] * LOG2E)); }
                            *(f32x4*)gp = s0; *(f32x4*)(gp + 4) = s1; }
                    } else {
                        const bool isq = pn < 4; const bool rp = isq || ((ropemask >> (pn - 4)) & 1);
                        bf16_t* dst = isq ? Q + (size_t)row * DM + pn * 256 + hl * 64
                                          : KV + (size_t)(pn - 4) * kvstride + ((size_t)(b * NKV + hl) * SEQ + t) * HD;
                        if (rp) {
                            const f32x4 cs = *(const f32x4*)(rope + (size_t)t * 64 + j4), sn = *(const f32x4*)(rope + (size_t)t * 64 + 32 + j4);
                            f32x4 o1 = v0 * cs - v1 * sn, o2 = v1 * cs + v0 * sn;
                            if (isq) { o1 = o1 * QSCALE; o2 = o2 * QSCALE; }
                            u32x2 w1, w2; w1.x = cvt_pk_bf16(o1[0], o1[1]); w1.y = cvt_pk_bf16(o1[2], o1[3]); w2.x = cvt_pk_bf16(o2[0], o2[1]); w2.y = cvt_pk_bf16(o2[2], o2[3]);
                            *(u32x2*)(dst + j4) = w1; *(u32x2*)(dst + 32 + j4) = w2;
                        } else {
                            u32x4 w; w.x = cvt_pk_bf16(v0[0], v0[1]); w.y = cvt_pk_bf16(v0[2], v0[3]); w.z = cvt_pk_bf16(v1[0], v1[1]); w.w = cvt_pk_bf16(v1[2], v1[3]);
                            *(u32x4*)(dst + (c0 & 63)) = w;
                        }
                    }
                }
            }
    }
};
struct EpiResid {
    static constexpr bool PERM = false;
    float* Y; const bf16_t* R;
    __device__ __forceinline__ void operator()(const f32x4 (&acc)[2][2][4][2], const Unit& u, int wr, int wc, int fr, int fq) const {
        const int row0 = u.pm * BM + wr * 64 + fr, col0 = u.pn * BM + wc * 32 + 4 * fq;
#pragma unroll
        for (int ai = 0; ai < 2; ++ai)
#pragma unroll
            for (int m = 0; m < 4; ++m) { const size_t off = (size_t)(row0 + ai * HALF + m * 16) * DM + col0;
#pragma unroll
                for (int bj = 0; bj < 2; ++bj)
#pragma unroll
                    for (int n = 0; n < 2; ++n) { const u32x2 rw = *(const u32x2*)(R + off + bj * HALF + n * 16);
                        f32x4 o = acc[ai][bj][m][n]; o[0] += DN_ALPHA * bf_lo(rw.x); o[1] += DN_ALPHA * bf_hi(rw.x); o[2] += DN_ALPHA * bf_lo(rw.y); o[3] += DN_ALPHA * bf_hi(rw.y);
                        *(f32x4*)(Y + off + bj * HALF + n * 16) = o; } }
    }
};
struct EpiSwiglu {
    static constexpr bool PERM = true;
    bf16_t* H; int ldh; int row_sub;
    __device__ __forceinline__ void operator()(const f32x4 (&acc)[2][2][4][2], const Unit& u, int wr, int wc, int fr, int fq) const {
        const int row0 = u.pm * BM - row_sub + wr * 64 + fr, col0 = u.pn * HALF + wc * 32 + 8 * fq;
#pragma unroll
        for (int ai = 0; ai < 2; ++ai)
#pragma unroll
            for (int m = 0; m < 4; ++m) { bf16_t* rowp = H + (size_t)(row0 + ai * HALF + m * 16) * ldh + col0; float o[8];
#pragma unroll
                for (int n = 0; n < 2; ++n)
#pragma unroll
                    for (int k = 0; k < 4; ++k) { const float gv = acc[ai][0][m][n][k], uv = acc[ai][1][m][n][k];
                        o[4 * n + k] = gv * __builtin_amdgcn_rcpf(1.f + __builtin_amdgcn_exp2f(-gv * LOG2E)) * uv; }
                u32x4 w; w.x = cvt_pk_bf16(o[0], o[1]); w.y = cvt_pk_bf16(o[2], o[3]); w.z = cvt_pk_bf16(o[4], o[5]); w.w = cvt_pk_bf16(o[6], o[7]);
                *(u32x4*)rowp = w; }
    }
};
template <int ACT> struct EpiBf16 {
    static constexpr bool PERM = true;
    bf16_t* O; int ldc; const float* bias;
    __device__ __forceinline__ void operator()(const f32x4 (&acc)[2][2][4][2], const Unit& u, int wr, int wc, int fr, int fq) const {
        const int row0 = u.pm * BM + wr * 64 + fr, col0 = u.pn * BM + wc * 32 + 8 * fq;
#pragma unroll
        for (int ai = 0; ai < 2; ++ai)
#pragma unroll
            for (int m = 0; m < 4; ++m) { bf16_t* rowp = O + (size_t)(row0 + ai * HALF + m * 16) * ldc + col0;
#pragma unroll
                for (int bj = 0; bj < 2; ++bj) { f32x4 v0 = acc[ai][bj][m][0], v1 = acc[ai][bj][m][1];
                    if (ACT == 1) { const f32x4 b0 = *(const f32x4*)(bias + col0 + bj * HALF), b1 = *(const f32x4*)(bias + col0 + bj * HALF + 4); v0 = v0 + b0; v1 = v1 + b1;
#pragma unroll
                        for (int k = 0; k < 4; ++k) {
                            { const float x = v0[k], z = 1.5957691216057308f * (x + 0.044715f * x * x * x); v0[k] = x * __builtin_amdgcn_rcpf(1.f + __builtin_amdgcn_exp2f(-z * LOG2E)); }
                            { const float x = v1[k], z = 1.5957691216057308f * (x + 0.044715f * x * x * x); v1[k] = x * __builtin_amdgcn_rcpf(1.f + __builtin_amdgcn_exp2f(-z * LOG2E)); } } }
                    u32x4 w; w.x = cvt_pk_bf16(v0[0], v0[1]); w.y = cvt_pk_bf16(v0[2], v0[3]); w.z = cvt_pk_bf16(v1[0], v1[1]); w.w = cvt_pk_bf16(v1[2], v1[3]);
                    *(u32x4*)(rowp + bj * HALF) = w; } }
    }
};
}

constexpr size_t MiB = 1u << 20;
constexpr size_t WS_CTL = 0, CTL_ZERO_BYTES = 64 * 1024;
constexpr size_t WS_ROPE = 1 * MiB;
constexpr size_t WS_ROUTE = 2 * MiB;
constexpr size_t WS_KCC = 3 * MiB, WS_VCC = 4 * MiB;
constexpr size_t WS_MISC = 5 * MiB;
constexpr size_t WS_GATES = 6 * MiB;
constexpr size_t WS_WA_IN = 16 * MiB, WS_WA_OUT = 19 * MiB, WS_WB_IN = 21 * MiB, WS_WB_OUT = 27 * MiB, WS_CW1K = 29 * MiB, WS_CW1V = 30 * MiB;
constexpr size_t WS_FFN_GU = 31 * MiB, WS_FFN_D = 45 * MiB, WS_MOE_GU = 52 * MiB, WS_MOE_D = 164 * MiB;
constexpr size_t WS_ACT = 220 * MiB;
constexpr size_t WS_XB = WS_ACT;
constexpr size_t WS_Q = WS_ACT + 64 * MiB;
constexpr size_t WS_KV = WS_ACT + 128 * MiB;
constexpr size_t KV_STRIDE_B = 16 * MiB;
constexpr size_t WS_HFF = WS_ACT;
constexpr size_t WS_X1B = WS_ACT + 224 * MiB;
constexpr size_t WS_CHID = WS_ACT + 224 * MiB;
constexpr size_t WS_X3B = WS_ACT;
constexpr size_t WS_XG = WS_ACT + 64 * MiB;
constexpr size_t WS_HMOE = WS_ACT + 196 * MiB;
constexpr size_t WS_END = WS_ACT + 308 * MiB;
static_assert(WS_MOE_D + 8 * 7 * MiB <= WS_ACT && WS_X1B + 64 * MiB <= WS_END && WS_HMOE + 112 * MiB <= WS_END && WS_XG + 132 * MiB <= WS_HMOE, "d_ws map");
constexpr int CW_CNT = 64;
constexpr int CW_BAR = 1024;

constexpr int RING_BYTES = 131072, LDSCTL_OFF = 135168, LDS_BYTES = 147456;

#define XB_TMO      128
#define XB_XCNT(j)  (256  + 64 * (j))
#define XB_XSUB(j)  (1280 + 64 * (j))
#define XB_XGEN(j)  (2304 + 64 * (j))
#define XB_TOP      3328
#define XB_TOPGEN   3392
#define XCD_BAR_WORDS 3456
#define XB_SPIN_CAP (1u << 18)
static_assert((CW_BAR + XCD_BAR_WORDS) * 4 <= (int)CTL_ZERO_BYTES, "CTL words inside the memset region");
__device__ __forceinline__ unsigned xb_ld(unsigned* p)              { return __hip_atomic_load(p, __ATOMIC_RELAXED, __HIP_MEMORY_SCOPE_AGENT); }
__device__ __forceinline__ unsigned xb_add(unsigned* p, unsigned v) { return __hip_atomic_fetch_add(p, v, __ATOMIC_RELAXED, __HIP_MEMORY_SCOPE_AGENT); }
__device__ __forceinline__ unsigned xb_xcc_id() { return (unsigned)__builtin_amdgcn_s_getreg((3 << 11) | 20) & 0xFu; }
#define XB_SPIN(cond, bar) do { unsigned _sp = 0; while (cond) { __builtin_amdgcn_s_sleep(1); \
    if ((++_sp & 255u) == 0u) { if (xb_ld(&(bar)[XB_TMO])) break; if (_sp > XB_SPIN_CAP) { atomicAdd(&(bar)[XB_TMO], 1u); break; } } } } while (0)
struct XcdBarrier { unsigned* bar; unsigned x; volatile LAS unsigned* st; };
__device__ __forceinline__ XcdBarrier xcd_barrier_post(unsigned* bar, volatile LAS unsigned* st) {
    XcdBarrier b; b.bar = bar; b.x = xb_xcc_id(); b.st = st;
    if (threadIdx.x == 0) (void)xb_add(&bar[XB_XCNT(b.x)], 1u);
    return b;
}
__device__ __forceinline__ void xcd_barrier_complete(unsigned* bar, unsigned x, unsigned& nloc, unsigned& nx) {
    const unsigned G = gridDim.x * gridDim.y * gridDim.z;
    unsigned sum, cnt, mine, sp = 0u;
    for (;;) {
        sum = 0u; cnt = 0u; mine = 0u;
#pragma unroll
        for (unsigned j = 0; j < 16; ++j) { const unsigned c = xb_ld(&bar[XB_XCNT(j)]); sum += c; cnt += (c > 0u) ? 1u : 0u; mine = (j == x) ? c : mine; }
        if (sum == G) break;
        __builtin_amdgcn_s_sleep(1);
        if ((++sp & 255u) == 0u) { if (xb_ld(&bar[XB_TMO])) break; if (sp > XB_SPIN_CAP) { atomicAdd(&bar[XB_TMO], 1u); break; } }
    }
    nloc = mine > 0u ? mine : 1u; nx = cnt > 0u ? cnt : 1u;
}
__device__ __forceinline__ void xcd_barrier(const XcdBarrier& b) {
    asm volatile("s_waitcnt vmcnt(0)" ::: "memory");
    __syncthreads();
    if (threadIdx.x == 0) {
        unsigned* bar = b.bar;
        __builtin_amdgcn_s_waitcnt(0);
        unsigned nloc = b.st[0], nx = b.st[1];
        if (nloc == 0u) { xcd_barrier_complete(bar, b.x, nloc, nx); b.st[0] = nloc; b.st[1] = nx; }
        const unsigned old = xb_add(&bar[XB_XSUB(b.x)], 1u);
        const unsigned gen = old / nloc;
        if (old + 1u == (gen + 1u) * nloc) {
            __builtin_amdgcn_fence(__ATOMIC_RELEASE, "agent");
            asm volatile("s_waitcnt vmcnt(0)" ::: "memory");
            const unsigned og = xb_add(&bar[XB_TOP], 1u);
            const unsigned tg = og / nx;
            if (og + 1u == (tg + 1u) * nx) xb_add(&bar[XB_TOPGEN], 1u);
            else XB_SPIN(xb_ld(&bar[XB_TOPGEN]) == tg, bar);
            __builtin_amdgcn_fence(__ATOMIC_ACQUIRE, "agent");
            xb_add(&bar[XB_XGEN(b.x)], 1u);
            asm volatile("s_waitcnt vmcnt(0)" ::: "memory");
        } else {
            XB_SPIN(xb_ld(&bar[XB_XGEN(b.x)]) == gen, bar);
            __builtin_amdgcn_fence(__ATOMIC_ACQUIRE, "agent");
            asm volatile("s_waitcnt vmcnt(0)" ::: "memory");
        }
    }
    __syncthreads();
}

__device__ __forceinline__ float wave_sum(float v) {
#pragma unroll
    for (int o = 1; o < 64; o <<= 1) v += __shfl_xor(v, o);
    return v;
}
__device__ __forceinline__ unsigned f2bf(float f) { unsigned u = __float_as_uint(f); return (u + 0x7fffu + ((u >> 16) & 1u)) >> 16; }
__device__ __forceinline__ unsigned pk2(float lo, float hi) { return f2bf(lo) | (f2bf(hi) << 16); }
#define LDS_WAIT() asm volatile("s_waitcnt lgkmcnt(0)" ::: "memory")

__device__ __forceinline__ int wmap(int mode, int n) {
    if (mode == 1) { const int h = n & ~63, d = n & 63; return h + (d < 32 ? 8 * (d >> 2) + (d & 3) : 8 * ((d - 32) >> 2) + 4 + (d & 3)); }
    if (mode == 2) return ((n >> 7) << 8) + (n & 127);
    if (mode == 3) return ((n >> 7) << 8) + 128 + (n & 127);
    return n;
}
__device__ __forceinline__ void transpose_item(const float* W, int K, int N, bf16_t* WT, int row_off, int mode, LAS float* scr, int item, int lane) {
    const int nblk = (N + 31) / 32, kb = item / nblk, nb = item % nblk, k0 = 64 * kb, n0 = 32 * nb;
    const int nn = n0 + (lane & 31); const bool nok = nn < N;
#pragma unroll 8
    for (int i = 0; i < 32; ++i) { const int kk = 2 * i + (lane >> 5); scr[kk * 33 + (lane & 31)] = nok ? W[(size_t)(k0 + kk) * N + nn] : 0.f; }
    LDS_WAIT(); asm volatile("" ::: "memory");
    const int c = lane & 7;
#pragma unroll
    for (int j = 0; j < 4; ++j) { const int n = (lane >> 3) + 8 * j; const LAS float* s = scr + (8 * c) * 33 + n;
        u32x4 o; o.x = pk2(s[0 * 33], s[1 * 33]); o.y = pk2(s[2 * 33], s[3 * 33]); o.z = pk2(s[4 * 33], s[5 * 33]); o.w = pk2(s[6 * 33], s[7 * 33]);
        if (n0 + n < N) *(u32x4*)(WT + (size_t)(row_off + wmap(mode, n0 + n)) * K + k0 + 8 * c) = o; }
    LDS_WAIT(); asm volatile("" ::: "memory");
}

namespace att {
constexpr float NEG_INF = -__builtin_huge_valf();
struct St { float m, l; f32x16 o0, o1; };
__device__ __forceinline__ void st_init(St& s, float m0, float l0) { s.m = m0; s.l = l0;
#pragma unroll
    for (int r = 0; r < 16; ++r) { s.o0[r] = 0.f; s.o1[r] = 0.f; } }
__device__ __forceinline__ float xhalf(float v) { return __shfl_xor(v, 32); }
__device__ __forceinline__ void kv_fetch(const bf16_t* Kg, const bf16_t* Vg, int wid, int lane, u32x4& kreg, u32x4& vreg) {
    kreg = *(const u32x4*)(Kg + lane * 64 + wid * 8);
    vreg = *(const u32x4*)(Vg + (16 * (wid & 3) + (lane >> 2)) * 64 + (wid >> 2) * 32 + (lane & 3) * 8);
}
__device__ __forceinline__ void kv_store(LAS unsigned char* Ks, LAS unsigned char* Vs, int wid, int lane, const u32x4& kreg, const u32x4& vreg) {
    *(LAS u32x4*)(Ks + wid * 1024 + lane * 16) = kreg; *(LAS u32x4*)(Vs + wid * 1024 + lane * 16) = vreg;
}
__device__ __forceinline__ s16x4 vtr(const LAS unsigned char* p) { typedef short v4i16_t __attribute__((ext_vector_type(4)));
    return __builtin_bit_cast(s16x4, __builtin_amdgcn_ds_read_tr16_b64_v4i16((LAS v4i16_t*)p)); }
__device__ __forceinline__ void qkt(f32x16& p0, f32x16& p1, const LAS unsigned char* Ks, const bf16x8 (&qr)[4], int lane) {
    const LAS unsigned char* kp = Ks + (lane >> 5) * 1024 + (lane & 31) * 16;
#pragma unroll
    for (int r = 0; r < 16; ++r) { p0[r] = 0.f; p1[r] = 0.f; }
#pragma unroll
    for (int d0 = 0; d0 < 4; ++d0) {
        const bf16x8 b0 = *(const LAS bf16x8*)(kp + d0 * 2048), b1 = *(const LAS bf16x8*)(kp + d0 * 2048 + 512);
        p0 = __builtin_amdgcn_mfma_f32_32x32x16_bf16(b0, qr[d0], p0, 0, 0, 0);
        p1 = __builtin_amdgcn_mfma_f32_32x32x16_bf16(b1, qr[d0], p1, 0, 0, 0);
    }
}
__device__ __forceinline__ void kmask(f32x16& p0, f32x16& p1, int lo_c, int hi_c, int lane) {
    const int base = 4 * (lane >> 5) - lo_c; const unsigned span = (unsigned)(hi_c - lo_c);
#pragma unroll
    for (int r = 0; r < 16; ++r) { const int kv = (r & 3) + 8 * (r >> 2);
        if ((unsigned)(kv + base) > span) p0[r] = NEG_INF;
        if ((unsigned)(kv + 32 + base) > span) p1[r] = NEG_INF; }
}
__device__ __forceinline__ void pv(f32x16& o0, f32x16& o1, const f32x16& p0, const f32x16& p1, const LAS unsigned char* Vs, int lane) {
    const LAS unsigned char* vp = Vs + ((lane >> 4) & 1) * 32 + (lane & 3) * 8 + (4 * (lane >> 5) + ((lane & 15) >> 2)) * 64;
    u32x4 pw[4];
#pragma unroll
    for (int i = 0; i < 4; ++i) { pw[0][i] = cvt_pk_bf16(p0[2 * i], p0[2 * i + 1]); pw[1][i] = cvt_pk_bf16(p0[8 + 2 * i], p0[9 + 2 * i]);
                                  pw[2][i] = cvt_pk_bf16(p1[2 * i], p1[2 * i + 1]); pw[3][i] = cvt_pk_bf16(p1[8 + 2 * i], p1[9 + 2 * i]); }
#pragma unroll
    for (int s = 0; s < 4; ++s) {
        const s16x4 l0 = vtr(vp + s * 1024), h0 = vtr(vp + s * 1024 + 512), l1 = vtr(vp + 4096 + s * 1024), h1 = vtr(vp + 4096 + s * 1024 + 512);
        const bf16x8 v0 = (bf16x8){l0[0], l0[1], l0[2], l0[3], h0[0], h0[1], h0[2], h0[3]}, v1 = (bf16x8){l1[0], l1[1], l1[2], l1[3], h1[0], h1[1], h1[2], h1[3]};
        const bf16x8 pa = __builtin_bit_cast(bf16x8, pw[s]);
        o0 = __builtin_amdgcn_mfma_f32_32x32x16_bf16(v0, pa, o0, 0, 0, 0);
        o1 = __builtin_amdgcn_mfma_f32_32x32x16_bf16(v1, pa, o1, 0, 0, 0);
    }
}
__device__ __forceinline__ float rowmax(const f32x16& p0, const f32x16& p1) {
    float a = fmaxf(p0[0], p1[0]);
#pragma unroll
    for (int r = 1; r < 16; ++r) a = fmaxf(a, fmaxf(p0[r], p1[r]));
    return fmaxf(a, xhalf(a));
}
template <bool MASK, bool PV>
__device__ __forceinline__ void block(const LAS unsigned char* Ks, const LAS unsigned char* Vs, const bf16x8 (&qr)[4], St& st, int lo_c, int hi_c, bool lane_on, int lane) {
    f32x16 p0, p1; qkt(p0, p1, Ks, qr, lane);
    if (MASK) kmask(p0, p1, lo_c, hi_c, lane);
    float rm = rowmax(p0, p1); rm = lane_on ? rm : NEG_INF;
    const float mn = fmaxf(st.m, rm), alpha = __builtin_amdgcn_exp2f(st.m - mn), mu = lane_on ? mn : -NEG_INF;
    float sum = 0.f;
#pragma unroll
    for (int r = 0; r < 16; ++r) { p0[r] = __builtin_amdgcn_exp2f(p0[r] - mu); p1[r] = __builtin_amdgcn_exp2f(p1[r] - mu); sum += p0[r] + p1[r]; }
    st.l = st.l * alpha + sum; st.m = mn;
    if (PV) {
#pragma unroll
        for (int r = 0; r < 16; ++r) { st.o0[r] *= alpha; st.o1[r] *= alpha; }
        pv(st.o0, st.o1, p0, p1, Vs, lane);
    }
}
template <bool PV>
__device__ __forceinline__ void block_any(const LAS unsigned char* Ks, const LAS unsigned char* Vs, const bf16x8 (&qr)[4], St& st, int lo_rel, int hi_rel, bool extra_on, int lane) {
    const bool on = extra_on && hi_rel >= 0 && lo_rel <= 63;
    if (!__any(on)) return;
    const int lo_c = lo_rel < 0 ? 0 : lo_rel, hi_c = hi_rel > 63 ? 63 : hi_rel;
    if (__any(on && (lo_c > 0 || hi_c < 63))) block<true, PV>(Ks, Vs, qr, st, lo_c, hi_c, on, lane);
    else block<false, PV>(Ks, Vs, qr, st, 0, 63, on, lane);
}
__device__ __forceinline__ void load_q(bf16x8 (&qr)[4], const bf16_t* Qrow  , int lane) {
#pragma unroll
    for (int d0 = 0; d0 < 4; ++d0) qr[d0] = *(const bf16x8*)(Qrow + d0 * 16 + (lane >> 5) * 8);
}
__device__ __forceinline__ void fold(f32x16& a0, f32x16& a1, const St& st, float w) {
    const float lt = st.l + xhalf(st.l), sc = lt > 0.f ? w / lt : 0.f;
#pragma unroll
    for (int r = 0; r < 16; ++r) { a0[r] += sc * st.o0[r]; a1[r] += sc * st.o1[r]; }
}
__device__ __forceinline__ void store_o(bf16_t* Orow, const f32x16& a0, const f32x16& a1, int lane) {
    const int hi = lane >> 5;
#pragma unroll
    for (int r = 0; r < 16; r += 2) { const int d = (r & 3) + 8 * (r >> 2) + 4 * hi;
        *(unsigned*)(Orow + d) = cvt_pk_bf16(a0[r], a0[r + 1]); *(unsigned*)(Orow + 32 + d) = cvt_pk_bf16(a1[r], a1[r + 1]); }
}
}

__device__ __forceinline__ void swa_unit(LAS unsigned char* lds, int b, int kvh, int tile, const bf16_t* Q, const bf16_t* Kh, const bf16_t* Vh, bf16_t* O, const float* sinks) {
    int tid = threadIdx.x; asm volatile("" : "+v"(tid));
    const int lane = tid & 63, wid = __builtin_amdgcn_readfirstlane(tid >> 6), g = wid & 3, s = wid >> 2, r32 = lane & 31;
    const bf16_t* Kb = Kh + (size_t)(b * NKV + kvh) * SEQ * HD; const bf16_t* Vb = Vh + (size_t)(b * NKV + kvh) * SEQ * HD;
    u32x4 kr[3], vr[3];
#pragma unroll
    for (int i = 0; i < 3; ++i) { const int j = tile - 2 + i; if (j >= 0) att::kv_fetch(Kb + (size_t)j * 64 * HD, Vb + (size_t)j * 64 * HD, wid, lane, kr[i], vr[i]); }
    const int t = tile * 64 + s * 32 + r32, head = kvh * 4 + g;
    const size_t qoff = ((size_t)b * SEQ + t) * DM + head * HD;
    bf16x8 qr[4]; att::load_q(qr, Q + qoff, lane);
#pragma unroll
    for (int i = 0; i < 3; ++i) { const int j = tile - 2 + i; if (j >= 0) att::kv_store(lds + i * 8192, lds + 24576 + i * 8192, wid, lane, kr[i], vr[i]); }
    __syncthreads();
    att::St st; att::st_init(st, sinks[head] * LOG2E, (lane < 32) ? 1.f : 0.f);
#pragma unroll
    for (int i = 0; i < 3; ++i) { const int j = tile - 2 + i;
        if (j >= 0) att::block_any<true>(lds + i * 8192, lds + 24576 + i * 8192, qr, st, t - 127 - 64 * j, t - 64 * j, true, lane); }
    f32x16 a0, a1;
#pragma unroll
    for (int r = 0; r < 16; ++r) { a0[r] = 0.f; a1[r] = 0.f; }
    att::fold(a0, a1, st, 1.f);
    att::store_o(O + qoff, a0, a1, lane);
    __syncthreads();
}

static_assert(65536 + 4 * 64 * 65 * 4 <= LDSCTL_OFF, "NSA importance table below the LDS control words");
constexpr int NSA_IMP = 65536, NSA_IMPF = 0, NSA_SELM = 16640, NSA_SELU = 17152, NSA_KS = 32768, NSA_VS = 49152;
struct NsaT { const bf16_t* Q; bf16_t* O; const bf16_t *KS, *VS, *KW, *VW, *KCC, *VCC; const float* gates; };
__device__ __forceinline__ void nsa_unit(LAS unsigned char* lds, int b, int kvh, int tile, const NsaT& T) {
    int tid = threadIdx.x; asm volatile("" : "+v"(tid));
    const int lane = tid & 63, wid = __builtin_amdgcn_readfirstlane(tid >> 6), g = wid & 3, s = wid >> 2, r32 = lane & 31, hi = lane >> 5;
    const int t = tile * 64 + s * 32 + r32, head = kvh * 4 + g, cur = tile;
    const size_t qoff = ((size_t)b * SEQ + t) * DM + head * HD;
    const size_t bh = (size_t)(b * NKV + kvh);
    {
        const bf16_t* Kc = T.KCC + bh * 256 * HD; const bf16_t* Vc = T.VCC + bh * 256 * HD; u32x4 kr[4], vr[4];
#pragma unroll
        for (int i = 0; i < 4; ++i) att::kv_fetch(Kc + i * 64 * HD, Vc + i * 64 * HD, wid, lane, kr[i], vr[i]);
#pragma unroll
        for (int i = 0; i < 4; ++i) att::kv_store(lds + i * 8192, lds + 32768 + i * 8192, wid, lane, kr[i], vr[i]);
    }
    bf16x8 qr[4]; att::load_q(qr, T.Q + qoff, lane);
    const float* gp = T.gates + ((size_t)b * SEQ + t) * 48 + head * 3;
    const float g_c = gp[0], g_s = gp[1], g_w = gp[2];
    __syncthreads();
    f32x16 a0, a1;
#pragma unroll
    for (int r = 0; r < 16; ++r) { a0[r] = 0.f; a1[r] = 0.f; }
    const int iv = (t - 31) >> 4;
    {
        att::St st; att::st_init(st, -1e30f, 0.f);
#pragma unroll 1
        for (int blk = 0; blk < 4; ++blk) att::block_any<false>(lds + blk * 8192, lds + 32768 + blk * 8192, qr, st, 0, iv - 64 * blk, true, lane);
        const float lt = st.l + att::xhalf(st.l), inv_l = lt > 0.f ? 1.f / lt : 0.f, mfin = st.m;
        f32x16 c0, c1;
#pragma unroll
        for (int r = 0; r < 16; ++r) { c0[r] = 0.f; c1[r] = 0.f; }
        int r32o = r32; asm volatile("" : "+v"(r32o));
        LAS float* imp_row = (LAS float*)(lds + NSA_IMP) + (g * 64 + s * 32 + r32o) * 65;
        float prevx = 0.f;
#pragma unroll 1
        for (int blk = 0; blk < 4; ++blk) {
            const int hi_rel = iv - 64 * blk; const bool on = hi_rel >= 0;
            if (!__any(on)) {
#pragma unroll
                for (int k = 0; k < 8; ++k) imp_row[16 * blk + 2 * k + hi] = 0.f;
                prevx = 0.f; continue;
            }
            f32x16 p0, p1; att::qkt(p0, p1, lds + blk * 8192, qr, lane);
            att::kmask(p0, p1, 0, hi_rel > 63 ? 63 : hi_rel, lane);
            const float mu = on ? mfin : -att::NEG_INF;
#pragma unroll
            for (int r = 0; r < 16; ++r) { p0[r] = __builtin_amdgcn_exp2f(p0[r] - mu) * inv_l; p1[r] = __builtin_amdgcn_exp2f(p1[r] - mu) * inv_l; }
#pragma unroll
            for (int tt = 0; tt < 2; ++tt)
#pragma unroll
                for (int r2 = 0; r2 < 4; ++r2) {
                    const float pa = tt ? p1[4 * r2] : p0[4 * r2], pb = tt ? p1[4 * r2 + 1] : p0[4 * r2 + 1], pc = tt ? p1[4 * r2 + 2] : p0[4 * r2 + 2], pd = tt ? p1[4 * r2 + 3] : p0[4 * r2 + 3];
                    float own = 2.f * (pa + pb + pc) + pd; const float other = att::xhalf(pd);
                    if (hi) own += other; else { own += prevx; prevx = other; }
                    imp_row[16 * blk + 8 * tt + 2 * r2 + hi] = own;
                }
            att::pv(c0, c1, p0, p1, lds + 32768 + blk * 8192, lane);
        }
#pragma unroll
        for (int r = 0; r < 16; ++r) { a0[r] = g_c * c0[r]; a1[r] = g_c * c1[r]; }
    }
    __syncthreads();
    {
        int tid2 = tid; asm volatile("" : "+v"(tid2));
        const int tok = tid2 >> 3, seg = tid2 & 7; const LAS float* ip = (const LAS float*)(lds + NSA_IMP); LAS float* impf = (LAS float*)(lds + NSA_IMPF);
        float v[8];
#pragma unroll
        for (int i = 0; i < 8; ++i) { const int j = 8 * seg + i;
            float x = (ip[(0 * 64 + tok) * 65 + j] + ip[(1 * 64 + tok) * 65 + j]) + (ip[(2 * 64 + tok) * 65 + j] + ip[(3 * 64 + tok) * 65 + j]);
            if (j == 0 || j == cur || j == cur - 1) x = 1e4f;
            if (j > cur) x = -1.f;
            v[i] = x; }
        if (tid < 2) ((LAS unsigned*)(lds + NSA_SELU))[tid] = 0u;
#pragma unroll
        for (int i = 0; i < 8; ++i) impf[tok * 65 + 8 * seg + i] = v[i];
        __syncthreads();
        int rank[8];
#pragma unroll
        for (int i = 0; i < 8; ++i) rank[i] = 0;
        for (int k = 0; k < 64; ++k) { const float x = impf[tok * 65 + k];
#pragma unroll
            for (int i = 0; i < 8; ++i) rank[i] += (x > v[i] || (x == v[i] && k < 8 * seg + i)) ? 1 : 0; }
        unsigned bits = 0;
#pragma unroll
        for (int i = 0; i < 8; ++i) bits |= (rank[i] < 16 ? 1u : 0u) << i;
        unsigned mlo = seg < 4 ? bits << (8 * seg) : 0u, mhi = seg >= 4 ? bits << (8 * (seg - 4)) : 0u;
#pragma unroll
        for (int o = 1; o < 8; o <<= 1) { mlo |= __shfl_xor(mlo, o); mhi |= __shfl_xor(mhi, o); }
        if (seg == 0) { LAS unsigned* sm = (LAS unsigned*)(lds + NSA_SELM); sm[2 * tok] = mlo; sm[2 * tok + 1] = mhi; }
        unsigned ulo = mlo, uhi = mhi;
#pragma unroll
        for (int o = 8; o < 64; o <<= 1) { ulo |= __shfl_xor(ulo, o); uhi |= __shfl_xor(uhi, o); }
        if (lane == 0) { __hip_atomic_fetch_or((LAS unsigned*)(lds + NSA_SELU), ulo, __ATOMIC_RELAXED, __HIP_MEMORY_SCOPE_WORKGROUP); __hip_atomic_fetch_or((LAS unsigned*)(lds + NSA_SELU) + 1, uhi, __ATOMIC_RELAXED, __HIP_MEMORY_SCOPE_WORKGROUP); }
        __syncthreads();
    }
    {
        const LAS unsigned* sm = (const LAS unsigned*)(lds + NSA_SELM);
        int r32o = r32; asm volatile("" : "+v"(r32o));
        const unsigned mlo = sm[2 * (s * 32 + r32o)], mhi = sm[2 * (s * 32 + r32o) + 1];
        const unsigned ulo = __builtin_amdgcn_readfirstlane(((const LAS unsigned*)(lds + NSA_SELU))[0]), uhi = __builtin_amdgcn_readfirstlane(((const LAS unsigned*)(lds + NSA_SELU))[1]);
        unsigned long long U = ((unsigned long long)uhi << 32) | ulo;
        if (cur < 63) U &= (1ull << (cur + 1)) - 1ull;
        const bf16_t* Kb = T.KS + bh * SEQ * HD; const bf16_t* Vb = T.VS + bh * SEQ * HD;
        att::St st; att::st_init(st, -1e30f, 0.f);
        int j = __builtin_ctzll(U | (1ull << 63)), slot = 0; u32x4 kr, vr;
        att::kv_fetch(Kb + (size_t)j * 64 * HD, Vb + (size_t)j * 64 * HD, wid, lane, kr, vr);
        att::kv_store(lds + NSA_KS, lds + NSA_VS, wid, lane, kr, vr);
        __syncthreads();
        for (;;) {
            const unsigned long long rest = (j >= 63) ? 0ull : (U & ~((2ull << j) - 1ull));
            const bool has_next = rest != 0ull; const int jn = has_next ? __builtin_ctzll(rest) : j;
            if (has_next) att::kv_fetch(Kb + (size_t)jn * 64 * HD, Vb + (size_t)jn * 64 * HD, wid, lane, kr, vr);
            const bool sel = ((j < 32 ? (mlo >> j) : (mhi >> (j - 32))) & 1u) != 0u;
            att::block_any<true>(lds + NSA_KS + slot * 8192, lds + NSA_VS + slot * 8192, qr, st, 0, t - 64 * j, sel, lane);
            if (has_next) att::kv_store(lds + NSA_KS + (slot ^ 1) * 8192, lds + NSA_VS + (slot ^ 1) * 8192, wid, lane, kr, vr);
            __syncthreads();
            if (!has_next) break;
            j = jn; slot ^= 1;
        }
        att::fold(a0, a1, st, g_s);
    }
    {
        const bf16_t* Kb = T.KW + bh * SEQ * HD; const bf16_t* Vb = T.VW + bh * SEQ * HD;
        att::St st; att::st_init(st, -1e30f, 0.f);
        int j = cur - 8 < 0 ? 0 : cur - 8, slot = 0; u32x4 kr, vr;
        att::kv_fetch(Kb + (size_t)j * 64 * HD, Vb + (size_t)j * 64 * HD, wid, lane, kr, vr);
        att::kv_store(lds + NSA_KS, lds + NSA_VS, wid, lane, kr, vr);
        __syncthreads();
        for (;;) {
            const bool has_next = j < cur;
            if (has_next) att::kv_fetch(Kb + (size_t)(j + 1) * 64 * HD, Vb + (size_t)(j + 1) * 64 * HD, wid, lane, kr, vr);
            att::block_any<true>(lds + NSA_KS + slot * 8192, lds + NSA_VS + slot * 8192, qr, st, t - 511 - 64 * j, t - 64 * j, true, lane);
            if (has_next) att::kv_store(lds + NSA_KS + (slot ^ 1) * 8192, lds + NSA_VS + (slot ^ 1) * 8192, wid, lane, kr, vr);
            __syncthreads();
            if (!has_next) break;
            ++j; slot ^= 1;
        }
        att::fold(a0, a1, st, g_w);
    }
    att::store_o(T.O + qoff, a0, a1, lane);
}

__device__ __forceinline__ void ln_apply(f32x4 (&v)[4], const float* gain, const float* bias, int lane) {
    float s = 0.f;
#pragma unroll
    for (int j = 0; j < 4; ++j) s += (v[j][0] + v[j][1]) + (v[j][2] + v[j][3]);
    const float mean = wave_sum(s) * (1.f / DM); float s2 = 0.f;
#pragma unroll
    for (int j = 0; j < 4; ++j) { v[j] = v[j] - mean; s2 += (v[j][0] * v[j][0] + v[j][1] * v[j][1]) + (v[j][2] * v[j][2] + v[j][3] * v[j][3]); }
    const float rstd = 1.f / sqrtf(wave_sum(s2) * (1.f / DM) + LN_EPS);
#pragma unroll
    for (int j = 0; j < 4; ++j) { const f32x4 gg = *(const f32x4*)(gain + 4 * lane + 256 * j), bb = *(const f32x4*)(bias + 4 * lane + 256 * j); v[j] = v[j] * rstd * gg + bb; }
}
__device__ __forceinline__ void store_row_bf16(bf16_t* orow, const f32x4 (&v)[4], int lane) {
#pragma unroll
    for (int j = 0; j < 4; ++j) { u32x2 w; w.x = cvt_pk_bf16(v[j][0], v[j][1]); w.y = cvt_pk_bf16(v[j][2], v[j][3]); *(u32x2*)(orow + 4 * lane + 256 * j) = w; }
}
__device__ __forceinline__ void load_row_bf16(f32x4 (&v)[4], const bf16_t* row, int lane) {
#pragma unroll
    for (int j = 0; j < 4; ++j) { const u32x2 w = *(const u32x2*)(row + 4 * lane + 256 * j); v[j][0] = bf_lo(w.x); v[j][1] = bf_hi(w.x); v[j][2] = bf_lo(w.y); v[j][3] = bf_hi(w.y); }
}
__device__ __forceinline__ void moe_offsets(unsigned* ctl, int (&toff)[9]) {
    int acc = 0;
#pragma unroll
    for (int e = 0; e < 8; ++e) { toff[e] = acc; const int c = (int)__builtin_amdgcn_readfirstlane(__hip_atomic_load(ctl + CW_CNT + 64 * e, __ATOMIC_RELAXED, __HIP_MEMORY_SCOPE_AGENT)); acc += (c + 255) >> 8; }
    toff[8] = acc;
}
struct BOffMoe { int t1, t2, t3, t4, t5, t6, t7; size_t estride, tstride;
    __device__ __forceinline__ size_t operator()(const pg8::Unit& u) const {
        const int pm = u.pm; const int e = (pm >= t1) + (pm >= t2) + (pm >= t3) + (pm >= t4) + (pm >= t5) + (pm >= t6) + (pm >= t7);
        return (size_t)e * estride + (size_t)u.pn * tstride; } };
struct BOffCmp { __device__ __forceinline__ size_t operator()(const pg8::Unit& u) const { return (u.pm >= 32) ? (size_t)MiB : (size_t)0; } };
struct EpiCmp {
    static constexpr bool PERM = true;
    bf16_t* O; const float* bias;
    __device__ __forceinline__ void operator()(const f32x4 (&acc)[2][2][4][2], const pg8::Unit& u, int wr, int wc, int fr, int fq) const {
        pg8::EpiBf16<1> e{O, 256, bias + ((u.pm >= 32) ? 256 : 0)}; e(acc, u, wr, wc, fr, fq);
    }
};

__device__ const double ROPE_INV[32] = {1.0, 0.7498942093324559, 0.5623413251903491, 0.4216965034285822, 0.31622776601683794, 0.23713737056616552, 0.1778279410038923, 0.1333521432163324,
    0.1, 0.07498942093324558, 0.05623413251903491, 0.042169650342858224, 0.03162277660168379, 0.023713737056616554, 0.01778279410038923, 0.01333521432163324,
    0.01, 0.007498942093324558, 0.005623413251903491, 0.004216965034285823, 0.0031622776601683794, 0.0023713737056616554, 0.0017782794100389228, 0.001333521432163324,
    0.001, 0.0007498942093324559, 0.0005623413251903491, 0.00042169650342858224, 0.00031622776601683794, 0.00023713737056616554, 0.00017782794100389227, 0.0001333521432163324};

constexpr int NPH = 26;
struct Args { const float* in[21]; float* out; unsigned char* ws; int ph_lo, ph_hi; };
enum { I_X = 0, I_AWIN, I_AWOUT, I_ASINK, I_BWIN, I_BWOUT, I_POSK, I_POSV, I_CKW1, I_CKW2, I_CVW1, I_CVW2, I_FG, I_FU, I_FD, I_ROUTER, I_MG, I_MU, I_MD, I_LNG, I_LNB };

__global__ void __launch_bounds__(512, 2) fwd(Args args) {
    extern __shared__ __attribute__((aligned(16))) unsigned char lds_raw[];
    LAS unsigned char* lds = (LAS unsigned char*)lds_raw;
    const int tid = threadIdx.x, lane = tid & 63, wave = __builtin_amdgcn_readfirstlane(tid >> 6);
    const int G = gridDim.x, wg = blockIdx.x, gw = wg * 8 + wave, NGW = G * 8;
    unsigned char* ws = args.ws;
    unsigned* ctl = (unsigned*)(ws + WS_CTL);
    const int lo = args.ph_lo, hi = args.ph_hi;
    volatile LAS unsigned* MISC = (volatile LAS unsigned*)(lds + LDSCTL_OFF);
    if (tid < 64) MISC[tid] = 0u;
    __syncthreads();
    XcdBarrier bar; bar.bar = ctl + CW_BAR; bar.x = 0; bar.st = MISC + 8;
    if (hi - lo > 1) bar = xcd_barrier_post(ctl + CW_BAR, MISC + 8);
#ifndef PHMASK
#define PHMASK 0xFFFFFFFFu
#endif
#define IN(k) (((PHMASK >> (k)) & 1u) && lo <= (k) && (k) < hi)
#define SEAM(k) do { if (IN(k) && IN((k) + 1)) xcd_barrier(bar); } while (0)
    bf16_t* const WA_IN = (bf16_t*)(ws + WS_WA_IN); bf16_t* const WA_OUT = (bf16_t*)(ws + WS_WA_OUT); bf16_t* const WB_IN = (bf16_t*)(ws + WS_WB_IN); bf16_t* const WB_OUT = (bf16_t*)(ws + WS_WB_OUT);
    bf16_t* const CW1 = (bf16_t*)(ws + WS_CW1K); bf16_t* const FFN_GU = (bf16_t*)(ws + WS_FFN_GU); bf16_t* const FFN_D = (bf16_t*)(ws + WS_FFN_D);
    bf16_t* const MOE_GU = (bf16_t*)(ws + WS_MOE_GU); bf16_t* const MOE_D = (bf16_t*)(ws + WS_MOE_D);
    float* const ROPE = (float*)(ws + WS_ROPE); float* const POSB = (float*)(ws + WS_MISC); bf16_t* const W2T = (bf16_t*)(ws + WS_MISC + 4096);
    float* const GATES = (float*)(ws + WS_GATES); bf16_t* const KCC = (bf16_t*)(ws + WS_KCC);
    bf16_t* const XB = (bf16_t*)(ws + WS_XB); bf16_t* const QB = (bf16_t*)(ws + WS_Q); bf16_t* const KVB = (bf16_t*)(ws + WS_KV);
    bf16_t* const HFF = (bf16_t*)(ws + WS_HFF); bf16_t* const X1B = (bf16_t*)(ws + WS_X1B); bf16_t* const CHID = (bf16_t*)(ws + WS_CHID);
    bf16_t* const X3B = (bf16_t*)(ws + WS_X3B); bf16_t* const XG = (bf16_t*)(ws + WS_XG); bf16_t* const HMOE = (bf16_t*)(ws + WS_HMOE);
    int* const ROUTE = (int*)(ws + WS_ROUTE);
    constexpr size_t KVS = KV_STRIDE_B / 2;

    if (IN(0)) {
        LAS float* scr = (LAS float*)(lds + wave * 16384);
        constexpr int I_A1 = 16 * 48, I_A2 = 16 * 32, I_B1 = 16 * 82, I_B2 = 16 * 32, I_C1 = 32 * 8, I_C2 = 4 * 2, I_F = 16 * 112, I_FDN = 56 * 32, I_ME = 2 * I_F + I_FDN;
        constexpr int NITEMS = I_A1 + I_A2 + I_B1 + I_B2 + 2 * I_C1 + 2 * I_C2 + 2 * I_F + I_FDN + 8 * I_ME;
        for (int it = gw; it < NITEMS; it += NGW) {
            int r = it;
            if (r < I_A1) { const int n0 = 32 * (r % 48); transpose_item(args.in[I_AWIN], 1024, 1536, WA_IN, 0, n0 < 1280 ? 1 : 0, scr, r, lane); continue; } r -= I_A1;
            if (r < I_A2) { transpose_item(args.in[I_AWOUT], 1024, 1024, WA_OUT, 0, 0, scr, r, lane); continue; } r -= I_A2;
            if (r < I_B1) { const int n0 = 32 * (r % 82); const bool rp = n0 < 1280 || (n0 >= 1536 && n0 < 1792) || (n0 >= 2048 && n0 < 2304);
                transpose_item(args.in[I_BWIN], 1024, NSA_IN, WB_IN, 0, rp ? 1 : 0, scr, r, lane); continue; } r -= I_B1;
            if (r < I_B2) { transpose_item(args.in[I_BWOUT], 1024, 1024, WB_OUT, 0, 0, scr, r, lane); continue; } r -= I_B2;
            if (r < I_C1) { transpose_item(args.in[I_CKW1], 2048, 256, CW1, 0, 0, scr, r, lane); continue; } r -= I_C1;
            if (r < I_C1) { transpose_item(args.in[I_CVW1], 2048, 256, CW1, 256, 0, scr, r, lane); continue; } r -= I_C1;
            if (r < I_C2) { transpose_item(args.in[I_CKW2], 256, 64, W2T, 0, 0, scr, r, lane); continue; } r -= I_C2;
            if (r < I_C2) { transpose_item(args.in[I_CVW2], 256, 64, W2T, 64, 0, scr, r, lane); continue; } r -= I_C2;
            if (r < I_F) { transpose_item(args.in[I_FG], 1024, DFF, FFN_GU, 0, 2, scr, r, lane); continue; } r -= I_F;
            if (r < I_F) { transpose_item(args.in[I_FU], 1024, DFF, FFN_GU, 0, 3, scr, r, lane); continue; } r -= I_F;
            if (r < I_FDN) { transpose_item(args.in[I_FD], DFF, 1024, FFN_D, 0, 0, scr, r, lane); continue; } r -= I_FDN;
            const int e = r / I_ME; r -= e * I_ME;
            if (r < I_F) { transpose_item(args.in[I_MG] + (size_t)e * 1024 * DFF, 1024, DFF, MOE_GU + (size_t)e * 2 * DFF * 1024, 0, 2, scr, r, lane); continue; } r -= I_F;
            if (r < I_F) { transpose_item(args.in[I_MU] + (size_t)e * 1024 * DFF, 1024, DFF, MOE_GU + (size_t)e * 2 * DFF * 1024, 0, 3, scr, r, lane); continue; } r -= I_F;
            transpose_item(args.in[I_MD] + (size_t)e * DFF * 1024, DFF, 1024, MOE_D + (size_t)e * 1024 * DFF, 0, 0, scr, r, lane);
        }
        for (int m = gw; m < TTOK; m += NGW) {
            f32x4 v[4];
#pragma unroll
            for (int j = 0; j < 4; ++j) v[j] = *(const f32x4*)(args.in[I_X] + (size_t)m * DM + 4 * lane + 256 * j);
            store_row_bf16(XB + (size_t)m * DM, v, lane);
        }
        for (int i = wg * 512 + tid; i < SEQ * 32; i += G * 512) {
            const int t = i >> 5, f = i & 31; const double rev = (double)t * ROPE_INV[f] * 0.15915494309189535; const float fr = (float)(rev - __builtin_rint(rev));
            ROPE[t * 64 + f] = __builtin_amdgcn_cosf(fr); ROPE[t * 64 + 32 + f] = __builtin_amdgcn_sinf(fr);
        }
        for (int o = gw; o < 512; o += NGW) {
            const float* pos = args.in[o < 256 ? I_POSK : I_POSV]; const float* w1 = args.in[o < 256 ? I_CKW1 : I_CVW1]; const int n = o & 255; float s = 0.f;
            for (int k = lane; k < 2048; k += 64) s += pos[k] * w1[(size_t)k * 256 + n];
            s = wave_sum(s); if (lane == 0) POSB[o] = s;
        }
        for (int i = wg * 512 + tid; i < (NSA_IN_PAD - NSA_IN) * 1024 / 8; i += G * 512) *(u32x4*)(WB_IN + (size_t)NSA_IN * 1024 + (size_t)i * 8) = (u32x4){0u, 0u, 0u, 0u};
    }
    SEAM(0);
    if (IN(1)) {
        pg8::Gemm g{XB, WA_IN, 1024, 1024}; pg8::StaticOrder S; S.init(128, 6, G, wg, 0);
        pg8::EpiProj E{QB, KVB, KVS, nullptr, ROPE, 1, -1};
        pg8::gemm_phase(lds, g, S, E, pg8::BOffPlain{1024});
    }
    SEAM(1);
    if (IN(2)) {
        for (int u = wg; u < 2048; u += G) { const int bk = u & 31; swa_unit(lds, bk >> 2, bk & 3, u >> 5, QB, KVB, KVB + KVS, QB, args.in[I_ASINK]); }
    }
    SEAM(2);
    if (IN(3)) {
        pg8::Gemm g{QB, WA_OUT, 1024, 1024}; pg8::StaticOrder S; S.init(128, 4, G, wg, 0);
        pg8::EpiResid E{args.out, XB};
        pg8::gemm_phase(lds, g, S, E, pg8::BOffPlain{1024});
    }
    SEAM(3);
    if (IN(4)) {
        for (int m = gw; m < TTOK; m += NGW) { f32x4 v[4];
#pragma unroll
            for (int j = 0; j < 4; ++j) v[j] = *(const f32x4*)(args.out + (size_t)m * DM + 4 * lane + 256 * j);
            ln_apply(v, args.in[I_LNG], args.in[I_LNB], lane); store_row_bf16(X1B + (size_t)m * DM, v, lane); }
    }
    SEAM(4);
    if (IN(5)) {
        pg8::Gemm g{X1B, FFN_GU, 1024, 1024}; pg8::StaticOrder S; S.init(128, 28, G, wg, 0);
        pg8::EpiSwiglu E{HFF, DFF, 0};
        pg8::gemm_phase(lds, g, S, E, pg8::BOffPlain{1024});
    }
    SEAM(5);
    if (IN(6)) {
        pg8::Gemm g{HFF, FFN_D, DFF, DFF}; pg8::StaticOrder S; S.init(128, 4, G, wg, 0);
        pg8::EpiResid E{args.out, X1B};
        pg8::gemm_phase(lds, g, S, E, pg8::BOffPlain{DFF});
    }
    SEAM(6);
    if (IN(7)) {
        for (int m = gw; m < TTOK; m += NGW) { f32x4 v[4];
#pragma unroll
            for (int j = 0; j < 4; ++j) v[j] = *(const f32x4*)(args.out + (size_t)m * DM + 4 * lane + 256 * j);
            ln_apply(v, args.in[I_LNG] + 1024, args.in[I_LNB] + 1024, lane); store_row_bf16(XB + (size_t)m * DM, v, lane); }
    }
    SEAM(7);
    if (IN(8)) {
        pg8::Gemm g{XB, WB_IN, 1024, 1024}; pg8::StaticOrder S; S.init(128, 11, G, wg, 0);
        pg8::EpiProj E{QB, KVB, KVS, GATES, ROPE, 0x15, 10};
        pg8::gemm_phase(lds, g, S, E, pg8::BOffPlain{1024});
    }
    SEAM(8);
    if (IN(9)) {
        pg8::Gemm g{KVB, CW1, 1024, 2048}; pg8::StaticOrder S; S.init(64, 1, G, wg, 0);
        EpiCmp E{CHID, POSB};
        pg8::gemm_phase(lds, g, S, E, BOffCmp{});
    }
    SEAM(9);
    if (IN(10)) {
        const int r32 = lane & 31, hh = lane >> 5;
        for (int task = gw; task < 512; task += NGW) {
            const int row0 = task * 32, which = row0 >> 13; const bf16_t* Hrow = CHID + (size_t)(row0 + r32) * 256; const bf16_t* Wt = W2T + which * 64 * 256;
            f32x16 c0, c1;
#pragma unroll
            for (int r = 0; r < 16; ++r) { c0[r] = 0.f; c1[r] = 0.f; }
#pragma unroll
            for (int ks = 0; ks < 16; ++ks) { const bf16x8 a = *(const bf16x8*)(Hrow + ks * 16 + hh * 8), b0 = *(const bf16x8*)(Wt + r32 * 256 + ks * 16 + hh * 8), b1 = *(const bf16x8*)(Wt + (32 + r32) * 256 + ks * 16 + hh * 8);
                c0 = __builtin_amdgcn_mfma_f32_32x32x16_bf16(a, b0, c0, 0, 0, 0); c1 = __builtin_amdgcn_mfma_f32_32x32x16_bf16(a, b1, c1, 0, 0, 0); }
#pragma unroll
            for (int r = 0; r < 16; ++r) { const int grow = row0 + (r & 3) + 8 * (r >> 2) + 4 * hh; const bool z = (grow & 255) == 255;
                KCC[(size_t)grow * 64 + r32] = (bf16_t)f2bf(z ? 0.f : c0[r]); KCC[(size_t)grow * 64 + 32 + r32] = (bf16_t)f2bf(z ? 0.f : c1[r]); }
        }
    }
    SEAM(10);
    if (IN(11)) {
        const NsaT T{QB, QB, KVB + 2 * KVS, KVB + 3 * KVS, KVB + 4 * KVS, KVB + 5 * KVS, KCC, KCC + (size_t)8192 * 64, GATES};
        for (int u = wg; u < 2048; u += G) { const int bk = u & 31, rr = u >> 5, rnd = rr >> 3, q = rr & 7;
            const int tile = 63 - (8 * rnd + ((rnd & 1) ? 7 - q : q)); nsa_unit(lds, bk >> 2, bk & 3, tile, T); }
    }
    SEAM(11);
    if (IN(12)) {
        pg8::Gemm g{QB, WB_OUT, 1024, 1024}; pg8::StaticOrder S; S.init(128, 4, G, wg, 0);
        pg8::EpiResid E{args.out, XB};
        pg8::gemm_phase(lds, g, S, E, pg8::BOffPlain{1024});
    }
    SEAM(12);
    if (IN(13)) {
        f32x4 rw[16][2];
#pragma unroll
        for (int j = 0; j < 4; ++j)
#pragma unroll
            for (int k = 0; k < 4; ++k) { const float* rp = args.in[I_ROUTER] + (size_t)(4 * lane + 256 * j + k) * 8; rw[4 * j + k][0] = *(const f32x4*)rp; rw[4 * j + k][1] = *(const f32x4*)(rp + 4); }
        LAS int* cntl = (LAS int*)lds;
        for (int u = wg; u < TTOK / 128; u += G) {
            int c[8];
#pragma unroll
            for (int e = 0; e < 8; ++e) c[e] = 0;
            int me1 = 0, me2 = 0, ms1 = 0, ms2 = 0; float mw1 = 0.f, mw2 = 0.f;
            for (int i = 0; i < 16; ++i) {
                const int m = u * 128 + wave * 16 + i; f32x4 v[4];
#pragma unroll
                for (int j = 0; j < 4; ++j) v[j] = *(const f32x4*)(args.out + (size_t)m * DM + 4 * lane + 256 * j);
                ln_apply(v, args.in[I_LNG] + 2048, args.in[I_LNB] + 2048, lane); store_row_bf16(X3B + (size_t)m * DM, v, lane);
                float lg[8];
#pragma unroll
                for (int e = 0; e < 8; ++e) lg[e] = 0.f;
#pragma unroll
                for (int j = 0; j < 4; ++j)
#pragma unroll
                    for (int k = 0; k < 4; ++k) { const float x = v[j][k];
#pragma unroll
                        for (int e = 0; e < 4; ++e) { lg[e] += x * rw[4 * j + k][0][e]; lg[4 + e] += x * rw[4 * j + k][1][e]; } }
#pragma unroll
                for (int e = 0; e < 8; ++e) lg[e] = wave_sum(lg[e]);
                int e1 = 0; float v1 = lg[0];
#pragma unroll
                for (int e = 1; e < 8; ++e) if (lg[e] > v1) { v1 = lg[e]; e1 = e; }
                int e2 = -1; float v2 = 0.f;
#pragma unroll
                for (int e = 0; e < 8; ++e) if (e != e1 && (e2 < 0 || lg[e] > v2)) { v2 = lg[e]; e2 = e; }
                const float ex = __expf(v2 - v1), w1 = 1.f / (1.f + ex), w2 = ex * w1;
                int s1 = 0, s2 = 0;
#pragma unroll
                for (int e = 0; e < 8; ++e) { if (e == e1) s1 = c[e]; if (e == e2) s2 = c[e]; c[e] += (e == e1 || e == e2) ? 1 : 0; }
                if (lane == i) { me1 = e1; me2 = e2; ms1 = s1; ms2 = s2; mw1 = w1; mw2 = w2; }
            }
            __syncthreads();
            if (lane < 8) { int cv = 0;
#pragma unroll
                for (int e = 0; e < 8; ++e) if (lane == e) cv = c[e];
                cntl[wave * 8 + lane] = cv; }
            __syncthreads();
            if (tid < 8) { int tot = 0;
#pragma unroll
                for (int w = 0; w < 8; ++w) tot += cntl[w * 8 + tid];
                int base = (int)__hip_atomic_fetch_add(ctl + CW_CNT + 64 * tid, (unsigned)tot, __ATOMIC_RELAXED, __HIP_MEMORY_SCOPE_AGENT);
#pragma unroll
                for (int w = 0; w < 8; ++w) { cntl[64 + w * 8 + tid] = base; base += cntl[w * 8 + tid]; } }
            __syncthreads();
            if (lane < 16) { int* rp = ROUTE + (size_t)(u * 128 + wave * 16 + lane) * 8;
                rp[0] = me1; rp[1] = me2; rp[2] = cntl[64 + wave * 8 + me1] + ms1; rp[3] = cntl[64 + wave * 8 + me2] + ms2; ((float*)rp)[4] = mw1; ((float*)rp)[5] = mw2; }
        }
    }
    SEAM(13);
    if (IN(14)) {
        int toff[9]; moe_offsets(ctl, toff);
        for (int m = gw; m < TTOK; m += NGW) {
            const int* rp = ROUTE + (size_t)m * 8; const int e1 = __builtin_amdgcn_readfirstlane(rp[0]), e2 = __builtin_amdgcn_readfirstlane(rp[1]), s1 = __builtin_amdgcn_readfirstlane(rp[2]), s2 = __builtin_amdgcn_readfirstlane(rp[3]);
            int t1 = 0, t2 = 0;
#pragma unroll
            for (int e = 0; e < 8; ++e) { if (e == e1) t1 = toff[e]; if (e == e2) t2 = toff[e]; }
            const u32x4 a = *(const u32x4*)(X3B + (size_t)m * DM + lane * 8), b = *(const u32x4*)(X3B + (size_t)m * DM + 512 + lane * 8);
            bf16_t* d1 = XG + ((size_t)t1 * 256 + s1) * DM; bf16_t* d2 = XG + ((size_t)t2 * 256 + s2) * DM;
            *(u32x4*)(d1 + lane * 8) = a; *(u32x4*)(d1 + 512 + lane * 8) = b; *(u32x4*)(d2 + lane * 8) = a; *(u32x4*)(d2 + 512 + lane * 8) = b;
        }
    }
    SEAM(14);
    for (int c = 0; c < 5; ++c) {
        if (IN(15 + 2 * c)) {
            int toff[9]; moe_offsets(ctl, toff); const int nt = toff[8] - 64 * c; const int ntc = nt < 0 ? 0 : (nt > 64 ? 64 : nt);
            pg8::Gemm g{XG, MOE_GU, 1024, 1024}; pg8::StaticOrder S; S.init(ntc, 28, G, wg, 64 * c);
            pg8::EpiSwiglu E{HMOE, DFF, 64 * c * 256};
            pg8::gemm_phase(lds, g, S, E, BOffMoe{toff[1], toff[2], toff[3], toff[4], toff[5], toff[6], toff[7], (size_t)2 * DFF * 1024 * 2, (size_t)256 * 1024 * 2});
        }
        SEAM(15 + 2 * c);
        if (IN(16 + 2 * c)) {
            int toff[9]; moe_offsets(ctl, toff); const int nt = toff[8] - 64 * c; const int ntc = nt < 0 ? 0 : (nt > 64 ? 64 : nt);
            pg8::Gemm g{HMOE - (size_t)64 * c * 256 * DFF, MOE_D, DFF, DFF}; pg8::StaticOrder S; S.init(ntc, 4, G, wg, 64 * c);
            pg8::EpiBf16<0> E{XG, 1024, nullptr};
            pg8::gemm_phase(lds, g, S, E, BOffMoe{toff[1], toff[2], toff[3], toff[4], toff[5], toff[6], toff[7], (size_t)1024 * DFF * 2, (size_t)256 * DFF * 2});
        }
        SEAM(16 + 2 * c);
    }
    if (IN(25)) {
        int toff[9]; moe_offsets(ctl, toff);
        for (int m = gw; m < TTOK; m += NGW) {
            const int* rp = ROUTE + (size_t)m * 8; const int e1 = __builtin_amdgcn_readfirstlane(rp[0]), e2 = __builtin_amdgcn_readfirstlane(rp[1]), s1 = __builtin_amdgcn_readfirstlane(rp[2]), s2 = __builtin_amdgcn_readfirstlane(rp[3]);
            const float w1 = __uint_as_float(__builtin_amdgcn_readfirstlane(rp[4])), w2 = __uint_as_float(__builtin_amdgcn_readfirstlane(rp[5]));
            int t1 = 0, t2 = 0;
#pragma unroll
            for (int e = 0; e < 8; ++e) { if (e == e1) t1 = toff[e]; if (e == e2) t2 = toff[e]; }
            f32x4 x[4], y1[4], y2[4];
            load_row_bf16(x, X3B + (size_t)m * DM, lane); load_row_bf16(y1, XG + ((size_t)t1 * 256 + s1) * DM, lane); load_row_bf16(y2, XG + ((size_t)t2 * 256 + s2) * DM, lane);
#pragma unroll
            for (int j = 0; j < 4; ++j) x[j] = x[j] * DN_ALPHA + (y1[j] * w1 + y2[j] * w2);
            ln_apply(x, args.in[I_LNG] + 3072, args.in[I_LNB] + 3072, lane);
#pragma unroll
            for (int j = 0; j < 4; ++j) *(f32x4*)(args.out + (size_t)m * DM + 4 * lane + 256 * j) = x[j];
        }
    }
#undef IN
#undef SEAM
}

#ifndef MK_PER_PHASE
#define MK_PER_PHASE 0
#endif
extern "C" void kernel_launch(void* const* d_in, const int* in_sizes, int n_in, void* d_out, int out_size, void* d_ws, size_t ws_size, hipStream_t stream) {
    static int grid = 0;
    if (grid == 0) {
        if (n_in != 21 || in_sizes[0] != TTOK * DM || out_size != TTOK * DM || ws_size < WS_END) { fprintf(stderr, "kernel_launch: unexpected shapes (n_in %d, ws %zu < %zu?)\n", n_in, ws_size, (size_t)WS_END); grid = -1; return; }
        int dev = 0, cus = 0;
        if (hipGetDevice(&dev) != hipSuccess || hipDeviceGetAttribute(&cus, hipDeviceAttributeMultiprocessorCount, dev) != hipSuccess) { grid = -1; return; }
        if (hipFuncSetAttribute((const void*)fwd, hipFuncAttributeMaxDynamicSharedMemorySize, LDS_BYTES) != hipSuccess) { fprintf(stderr, "kernel_launch: hipFuncSetAttribute failed\n"); grid = -1; return; }
        int per_cu = 0;
        if (hipOccupancyMaxActiveBlocksPerMultiprocessor(&per_cu, (const void*)fwd, 512, LDS_BYTES) != hipSuccess || per_cu < 1) { fprintf(stderr, "kernel_launch: occupancy query says %d\n", per_cu); }
        (void)hipGetLastError();
        grid = cus;
    }
    if (grid < 0) return;
    (void)hipMemsetAsync((char*)d_ws + WS_CTL, 0, CTL_ZERO_BYTES, stream);
    Args a{};
    for (int i = 0; i < 21; ++i) a.in[i] = (const float*)d_in[i];
    a.out = (float*)d_out; a.ws = (unsigned char*)d_ws;
#if MK_PER_PHASE
    for (int p = 0; p < NPH; ++p) { a.ph_lo = p; a.ph_hi = p + 1; hipLaunchKernelGGL(fwd, dim3(grid), dim3(512), LDS_BYTES, stream, a); }
#else
    a.ph_lo = 0; a.ph_hi = NPH; hipLaunchKernelGGL(fwd, dim3(grid), dim3(512), LDS_BYTES, stream, a);
#endif
}
```

```cpp
#include <hip/hip_runtime.h>
#include <cstdio>
#include <cstdint>
#include <cmath>

#define LAS __attribute__((address_space(3)))
#define GAS __attribute__((address_space(1)))

typedef unsigned short bf16_t;
typedef short bf16x8 __attribute__((ext_vector_type(8)));
typedef short s16x4 __attribute__((ext_vector_type(4)));
typedef float f32x4 __attribute__((ext_vector_type(4)));
typedef float f32x2 __attribute__((ext_vector_type(2)));
typedef float f32x16 __attribute__((ext_vector_type(16)));
typedef unsigned u32x4 __attribute__((ext_vector_type(4)));
typedef unsigned u32x2 __attribute__((ext_vector_type(2)));

constexpr int NB = 8, SEQ = 4096, TTOK = NB * SEQ, DM = 1024, DFF = 3584, NEXP = 8, HD = 64, NKV = 4;
constexpr float DN_ALPHA = 1.4142135623730951f;
constexpr float LN_EPS = 1e-5f;
constexpr float QSCALE = 0.125f * 1.4426950408889634f;
constexpr float LOG2E = 1.4426950408889634f;
constexpr int NSA_IN = 2608, NSA_IN_PAD = 2816;

__device__ __forceinline__ unsigned cvt_pk_bf16(float lo, float hi) { unsigned r; asm volatile("v_cvt_pk_bf16_f32 %0, %1, %2" : "=v"(r) : "v"(lo), "v"(hi)); return r; }
__device__ __forceinline__ float bf_lo(unsigned w) { return __uint_as_float(w << 16); }
__device__ __forceinline__ float bf_hi(unsigned w) { return __uint_as_float(w & 0xffff0000u); }

namespace pg8 {
constexpr int BM = 256, BK = 64, HALF = 128, HTB = HALF * BK * 2, STAGE_BYTES = 8 * HTB, NXCD = 8, WGM = 8;
__host__ __device__ __forceinline__ int lds_byte(int r, int c) { const int st = (r >> 4) * 2 + (c >> 5), rr = r & 15, cc = c & 31, ob = rr * 64 + cc * 2; return st * 1024 + (ob ^ (((ob >> 9) & 1) << 5)); }
__host__ __device__ __forceinline__ void stage_rc(int b, int& R, int& C) { const int st = b / 1024, sb = b % 1024, swz = sb ^ (((sb >> 9) & 1) << 5); R = (st >> 1) * 16 + swz / 64; C = (st & 1) * 32 + (swz % 64) / 2; }
__host__ __device__ __forceinline__ int perm32(int rho) { const int n = rho >> 4, i = rho & 15; return 8 * (i >> 2) + 4 * n + (i & 3); }

struct Unit { int pm, pn; };
struct Gemm { const bf16_t* A; const bf16_t* Bt; int lda; int K; };

struct StaticOrder {
    int nM, nN, nwg, G, c, pm0;
    __device__ void init(int nM_, int nN_, int G_, int c_, int pm0_) { nM = nM_; nN = nN_; nwg = nM * nN; G = G_; c = c_; pm0 = pm0_; }
    __device__ bool next(int i, Unit& u) const {
        const long L = (long)i * G + c; if (L >= nwg) return false;
        int wgid = (int)L; { const int q = nwg / NXCD, r = nwg % NXCD, xcd = wgid % NXCD, off = wgid / NXCD; wgid = (xcd < r ? xcd * (q + 1) : r * (q + 1) + (xcd - r) * q) + off; }
        const int nig = WGM * nN, gid = wgid / nig, fm = gid * WGM, gsz = (nM - fm) < WGM ? (nM - fm) : WGM;
        u.pm = pm0 + fm + ((wgid % nig) % gsz); u.pn = (wgid % nig) / gsz; return true;
    }
};

template <class Epi, class Sched, class BOff>
__device__ __forceinline__ void gemm_phase(LAS unsigned char* lds, const Gemm g, const Sched& S, const Epi& E, const BOff& boff) {
    const int tid = threadIdx.x, wid = __builtin_amdgcn_readfirstlane(tid >> 6), lane = tid & 63, wr = wid >> 2, wc = wid & 3, fr = lane & 15, fq = lane >> 4;
    const int K = g.K, nt = K / BK;
    unsigned voffA[2], voffB[2];
#pragma unroll
    for (int i = 0; i < 2; ++i) { int R, C; stage_rc(tid * 16 + i * 8192, R, C); const int Rb = Epi::PERM ? ((R & ~31) + perm32(R & 31)) : R;
        voffA[i] = (unsigned)(R * g.lda + C) * 2u; voffB[i] = (unsigned)(Rb * K + C) * 2u; }
    const size_t kstep = (size_t)(BK * 2);
    const size_t hstepA = (size_t)HALF * g.lda * 2, hstepB = (size_t)HALF * K * 2;
    const size_t tstepA = 2 * hstepA;
    const unsigned ldsw = (unsigned)wid * 1024u;
    const int aoff = lds_byte(wr * 64 + fr, fq * 8), boffl = lds_byte(wc * 32 + fr, fq * 8);
#define PG8_SA(b, h) (((b) * 2 + (h)) * HTB)
#define PG8_SB(b, h) ((4 + (b) * 2 + (h)) * HTB)
#define PG8_STAGE(bufoff, gbase, voff) do { _Pragma("unroll") for (int _i = 0; _i < 2; ++_i) \
        __builtin_amdgcn_global_load_lds((const unsigned*)((const char*)(gbase) + (voff)[_i]), (LAS unsigned*)(lds + (bufoff) + ldsw + _i * 8192), 16, 0, 0); } while (0)
#define PG8_LDA(dst, b, h) do { _Pragma("unroll") for (int m = 0; m < 4; ++m) _Pragma("unroll") for (int k = 0; k < 2; ++k) dst[m][k] = *(const LAS bf16x8*)(lds + PG8_SA(b, h) + aoff + m * 2048 + k * 1024); } while (0)
#define PG8_LDB(dst, b, h) do { _Pragma("unroll") for (int n = 0; n < 2; ++n) _Pragma("unroll") for (int k = 0; k < 2; ++k) dst[n][k] = *(const LAS bf16x8*)(lds + PG8_SB(b, h) + boffl + n * 2048 + k * 1024); } while (0)
#define PG8_MMA(ai, bj, At, Bt) do { __builtin_amdgcn_s_setprio(1); _Pragma("unroll") for (int m = 0; m < 4; ++m) _Pragma("unroll") for (int n = 0; n < 2; ++n) _Pragma("unroll") for (int k = 0; k < 2; ++k) \
        acc[ai][bj][m][n] = __builtin_amdgcn_mfma_f32_16x16x32_bf16(Bt[n][k], At[m][k], acc[ai][bj][m][n], 0, 0, 0); __builtin_amdgcn_s_setprio(0); } while (0)
#define PG8_WAIT_V(n) asm volatile("s_waitcnt vmcnt(" #n ")" ::: "memory")
#define PG8_WAIT_L(n) asm volatile("s_waitcnt lgkmcnt(" #n ")" ::: "memory")
#define PG8_BAR __builtin_amdgcn_s_barrier()
#define PG8_SCHED __builtin_amdgcn_sched_barrier(0)
    Unit cur, nxt; int ui = 0;
    if (!S.next(0, cur)) return;
    f32x4 acc[2][2][4][2];
#pragma unroll
    for (int a = 0; a < 2; ++a)
#pragma unroll
        for (int b = 0; b < 2; ++b)
#pragma unroll
            for (int m = 0; m < 4; ++m)
#pragma unroll
                for (int n = 0; n < 2; ++n) acc[a][b][m][n] = (f32x4){0.f, 0.f, 0.f, 0.f};
    bf16x8 At[4][2], B0[2][2], B1[2][2];
    const char* cA = (const char*)g.A + (size_t)cur.pm * tstepA; const char* cB = (const char*)g.Bt + boff(cur);
    PG8_STAGE(PG8_SB(0, 0), cB, voffB); PG8_STAGE(PG8_SB(0, 1), cB + hstepB, voffB); PG8_STAGE(PG8_SA(0, 0), cA, voffA); PG8_STAGE(PG8_SA(0, 1), cA + hstepA, voffA);
    if (wr == 1) PG8_BAR;
    PG8_WAIT_V(2); PG8_BAR;
    PG8_STAGE(PG8_SB(1, 0), cB + kstep, voffB); PG8_STAGE(PG8_SA(1, 0), cA + kstep, voffA); PG8_STAGE(PG8_SB(1, 1), cB + hstepB + kstep, voffB);
    PG8_WAIT_V(6); PG8_BAR;
    for (;;) {
        const bool has_next = S.next(ui + 1, nxt);
        const char* nA = has_next ? (const char*)g.A + (size_t)nxt.pm * tstepA : cA; const char* nB = has_next ? (const char*)g.Bt + boff(nxt) : cB;
        for (int t = 0; t < nt; t += 2) {
            const bool last = (t == nt - 2);
            const char* a1 = cA + (size_t)(t + 1) * kstep;
            const char* a2 = last ? nA : cA + (size_t)(t + 2) * kstep; const char* b2 = last ? nB : cB + (size_t)(t + 2) * kstep;
            const char* a3 = a2 + kstep; const char* b3 = b2 + kstep;
            PG8_LDB(B0, 0, 0); PG8_LDB(B1, 0, 1); PG8_SCHED; PG8_LDA(At, 0, 0); PG8_STAGE(PG8_SA(1, 1), a1 + hstepA, voffA);
            PG8_WAIT_V(8); PG8_WAIT_L(0); PG8_BAR; PG8_MMA(0, 0, At, B0); PG8_MMA(0, 1, At, B1); PG8_BAR; PG8_SCHED;
            PG8_LDA(At, 0, 1); PG8_STAGE(PG8_SB(0, 0), b2, voffB); PG8_STAGE(PG8_SB(0, 1), b2 + hstepB, voffB); PG8_STAGE(PG8_SA(0, 0), a2, voffA);
            PG8_WAIT_V(8); PG8_WAIT_L(0); PG8_BAR; PG8_MMA(1, 0, At, B0); PG8_MMA(1, 1, At, B1); PG8_BAR; PG8_SCHED;
            PG8_LDB(B0, 1, 0); PG8_LDB(B1, 1, 1); PG8_SCHED; PG8_LDA(At, 1, 0); PG8_STAGE(PG8_SA(0, 1), a2 + hstepA, voffA);
            PG8_WAIT_V(8); PG8_WAIT_L(0); PG8_BAR; PG8_MMA(0, 0, At, B0); PG8_MMA(0, 1, At, B1); PG8_BAR; PG8_SCHED;
            PG8_LDA(At, 1, 1); PG8_STAGE(PG8_SB(1, 0), b3, voffB); PG8_STAGE(PG8_SB(1, 1), b3 + hstepB, voffB); PG8_STAGE(PG8_SA(1, 0), a3, voffA);
            PG8_WAIT_V(8); PG8_WAIT_L(0); PG8_BAR; PG8_MMA(1, 0, At, B0); PG8_MMA(1, 1, At, B1); PG8_BAR; PG8_SCHED;
        }
        if (wr == 0) PG8_BAR;
        E(acc, cur, wr, wc, fr, fq);
        if (!has_next) break;
#pragma unroll
        for (int a = 0; a < 2; ++a)
#pragma unroll
            for (int b = 0; b < 2; ++b)
#pragma unroll
                for (int m = 0; m < 4; ++m)
#pragma unroll
                    for (int n = 0; n < 2; ++n) acc[a][b][m][n] = (f32x4){0.f, 0.f, 0.f, 0.f};
        cur = nxt; cA = nA; cB = nB; ++ui;
        if (wr == 1) PG8_BAR;
    }
    PG8_WAIT_V(0);
    PG8_BAR;
#undef PG8_SA
#undef PG8_SB
#undef PG8_STAGE
#undef PG8_LDA
#undef PG8_LDB
#undef PG8_MMA
#undef PG8_WAIT_V
#undef PG8_WAIT_L
#undef PG8_BAR
#undef PG8_SCHED
}
struct BOffPlain { int K; __device__ __forceinline__ size_t operator()(const Unit& u) const { return (size_t)u.pn * 256 * K * 2; } };

struct EpiProj {
    static constexpr bool PERM = true;
    bf16_t* Q; bf16_t* KV; size_t kvstride; float* gates; const float* rope; int ropemask; int gate_tile; int natmask;
    __device__ __forceinline__ void operator()(const f32x4 (&acc)[2][2][4][2], const Unit& u, int wr, int wc, int fr, int fq) const {
        const int pn = u.pn;
        const int row00 = u.pm * BM + wr * 64 + fr;
        const int cw = wc * 32 + 8 * fq, j4 = (cw & 63) >> 1;
        if (pn == gate_tile) {
            if (cw < 48) {
#pragma unroll
                for (int ai = 0; ai < 2; ++ai)
#pragma unroll
                    for (int m = 0; m < 4; ++m) { const int row = row00 + ai * HALF + m * 16; float* gp = gates + (size_t)row * 48 + cw; const f32x4 v0 = acc[ai][0][m][0], v1 = acc[ai][0][m][1]; f32x4 s0, s1;
#pragma unroll
                        for (int k = 0; k < 4; ++k) { s0[k] = __builtin_amdgcn_rcpf(1.f + __builtin_amdgcn_exp2f(-v0[k] * LOG2E)); s1[k] = __builtin_amdgcn_rcpf(1.f + __builtin_amdgcn_exp2f(-v1[k] * LOG2E)); }
                        *(f32x4*)gp = s0; *(f32x4*)(gp + 4) = s1; }
            }
            return;
        }
        const bool isq = pn < 4; const bool rp = isq || ((ropemask >> (pn - 4)) & 1); const bool nat = !isq && ((natmask >> (pn - 4)) & 1);
        bf16_t* const base = isq ? Q + pn * 256 : KV + (size_t)(pn - 4) * kvstride;
        if (rp) {
            f32x4 cs[2][4], sn[2][4];
#pragma unroll
            for (int ai = 0; ai < 2; ++ai)
#pragma unroll
                for (int m = 0; m < 4; ++m) { const int t = (row00 + ai * HALF + m * 16) & (SEQ - 1); cs[ai][m] = *(const f32x4*)(rope + (size_t)t * 64 + j4); sn[ai][m] = *(const f32x4*)(rope + (size_t)t * 64 + 32 + j4); }
#pragma unroll
            for (int ai = 0; ai < 2; ++ai)
#pragma unroll
                for (int m = 0; m < 4; ++m) { const int row = row00 + ai * HALF + m * 16, t = row & (SEQ - 1), b = row >> 12;
#pragma unroll
                    for (int bj = 0; bj < 2; ++bj) { const int hl = (bj * HALF + cw) >> 6;
                        bf16_t* dst = isq ? base + (size_t)row * DM + hl * 64 : base + ((size_t)(b * NKV + hl) * SEQ + t) * HD;
                        const f32x4 v0 = acc[ai][bj][m][0], v1 = acc[ai][bj][m][1];
                        f32x4 o1 = v0 * cs[ai][m] - v1 * sn[ai][m], o2 = v1 * cs[ai][m] + v0 * sn[ai][m];
                        if (isq) { o1 = o1 * QSCALE; o2 = o2 * QSCALE; }
                        u32x4 w; w.x = cvt_pk_bf16(o1[0], o1[1]); w.y = cvt_pk_bf16(o1[2], o1[3]); w.z = cvt_pk_bf16(o2[0], o2[1]); w.w = cvt_pk_bf16(o2[2], o2[3]);
                        if (nat) { *(u32x2*)(dst + j4) = (u32x2){w.x, w.y}; *(u32x2*)(dst + 32 + j4) = (u32x2){w.z, w.w}; }
                        else *(u32x4*)(dst + (cw & 63)) = w; } }
        } else {
#pragma unroll
            for (int ai = 0; ai < 2; ++ai)
#pragma unroll
                for (int m = 0; m < 4; ++m) { const int row = row00 + ai * HALF + m * 16, t = row & (SEQ - 1), b = row >> 12;
#pragma unroll
                    for (int bj = 0; bj < 2; ++bj) { const int hl = (bj * HALF + cw) >> 6; bf16_t* dst = base + ((size_t)(b * NKV + hl) * SEQ + t) * HD + (cw & 63);
                        const f32x4 v0 = acc[ai][bj][m][0], v1 = acc[ai][bj][m][1];
                        u32x4 w; w.x = cvt_pk_bf16(v0[0], v0[1]); w.y = cvt_pk_bf16(v0[2], v0[3]); w.z = cvt_pk_bf16(v1[0], v1[1]); w.w = cvt_pk_bf16(v1[2], v1[3]);
                        *(u32x4*)dst = w; } }
        }
    }
};
struct EpiResid {
    static constexpr bool PERM = true;
    bf16_t* Y; const bf16_t* R;
    __device__ __forceinline__ void operator()(const f32x4 (&acc)[2][2][4][2], const Unit& u, int wr, int wc, int fr, int fq) const {
        const int row0 = u.pm * BM + wr * 64 + fr, col0 = u.pn * BM + wc * 32 + 8 * fq;
        u32x4 rw[2][4][2];
#pragma unroll
        for (int ai = 0; ai < 2; ++ai)
#pragma unroll
            for (int m = 0; m < 4; ++m) { const size_t off = (size_t)(row0 + ai * HALF + m * 16) * DM + col0;
#pragma unroll
                for (int bj = 0; bj < 2; ++bj) rw[ai][m][bj] = *(const u32x4*)(R + off + bj * HALF); }
#pragma unroll
        for (int ai = 0; ai < 2; ++ai)
#pragma unroll
            for (int m = 0; m < 4; ++m) { const size_t off = (size_t)(row0 + ai * HALF + m * 16) * DM + col0;
#pragma unroll
                for (int bj = 0; bj < 2; ++bj) { const u32x4 r4 = rw[ai][m][bj]; const f32x4 a = acc[ai][bj][m][0], b = acc[ai][bj][m][1]; u32x4 w;
                    w.x = cvt_pk_bf16(a[0] + DN_ALPHA * bf_lo(r4.x), a[1] + DN_ALPHA * bf_hi(r4.x)); w.y = cvt_pk_bf16(a[2] + DN_ALPHA * bf_lo(r4.y), a[3] + DN_ALPHA * bf_hi(r4.y));
                    w.z = cvt_pk_bf16(b[0] + DN_ALPHA * bf_lo(r4.z), b[1] + DN_ALPHA * bf_hi(r4.z)); w.w = cvt_pk_bf16(b[2] + DN_ALPHA * bf_lo(r4.w), b[3] + DN_ALPHA * bf_hi(r4.w));
                    *(u32x4*)(Y + off + bj * HALF) = w; } }
    }
};
struct EpiSwiglu {
    static constexpr bool PERM = true;
    bf16_t* H; int ldh; int row_sub;
    __device__ __forceinline__ void operator()(const f32x4 (&acc)[2][2][4][2], const Unit& u, int wr, int wc, int fr, int fq) const {
        const int row0 = u.pm * BM - row_sub + wr * 64 + fr, col0 = u.pn * HALF + wc * 32 + 8 * fq;
#pragma unroll
        for (int ai = 0; ai < 2; ++ai)
#pragma unroll
            for (int m = 0; m < 4; ++m) { bf16_t* rowp = H + (size_t)(row0 + ai * HALF + m * 16) * ldh + col0; float o[8];
#pragma unroll
                for (int n = 0; n < 2; ++n)
#pragma unroll
                    for (int k = 0; k < 4; ++k) { const float gv = acc[ai][0][m][n][k], uv = acc[ai][1][m][n][k];
                        o[4 * n + k] = gv * __builtin_amdgcn_rcpf(1.f + __builtin_amdgcn_exp2f(-gv * LOG2E)) * uv; }
                u32x4 w; w.x = cvt_pk_bf16(o[0], o[1]); w.y = cvt_pk_bf16(o[2], o[3]); w.z = cvt_pk_bf16(o[4], o[5]); w.w = cvt_pk_bf16(o[6], o[7]);
                *(u32x4*)rowp = w; }
    }
};
template <int ACT> struct EpiBf16 {
    static constexpr bool PERM = true;
    bf16_t* O; int ldc; const float* bias;
    __device__ __forceinline__ void operator()(const f32x4 (&acc)[2][2][4][2], const Unit& u, int wr, int wc, int fr, int fq) const {
        const int row0 = u.pm * BM + wr * 64 + fr, col0 = u.pn * BM + wc * 32 + 8 * fq;
#pragma unroll
        for (int ai = 0; ai < 2; ++ai)
#pragma unroll
            for (int m = 0; m < 4; ++m) { bf16_t* rowp = O + (size_t)(row0 + ai * HALF + m * 16) * ldc + col0;
#pragma unroll
                for (int bj = 0; bj < 2; ++bj) { f32x4 v0 = acc[ai][bj][m][0], v1 = acc[ai][bj][m][1];
                    if (ACT == 1) { const f32x4 b0 = *(const f32x4*)(bias + col0 + bj * HALF), b1 = *(const f32x4*)(bias + col0 + bj * HALF + 4); v0 = v0 + b0; v1 = v1 + b1;
#pragma unroll
                        for (int k = 0; k < 4; ++k) {
                            { const float x = v0[k], z = 1.5957691216057308f * (x + 0.044715f * x * x * x); v0[k] = x * __builtin_amdgcn_rcpf(1.f + __builtin_amdgcn_exp2f(-z * LOG2E)); }
                            { const float x = v1[k], z = 1.5957691216057308f * (x + 0.044715f * x * x * x); v1[k] = x * __builtin_amdgcn_rcpf(1.f + __builtin_amdgcn_exp2f(-z * LOG2E)); } } }
                    u32x4 w; w.x = cvt_pk_bf16(v0[0], v0[1]); w.y = cvt_pk_bf16(v0[2], v0[3]); w.z = cvt_pk_bf16(v1[0], v1[1]); w.w = cvt_pk_bf16(v1[2], v1[3]);
                    *(u32x4*)(rowp + bj * HALF) = w; } }
    }
};
}

constexpr size_t MiB = 1u << 20;
constexpr size_t WS_CTL = 0, CTL_ZERO_BYTES = 64 * 1024;
constexpr size_t WS_ROPE = 1 * MiB;
constexpr size_t WS_ROUTE = 2 * MiB;
constexpr size_t WS_KCC = 3 * MiB, WS_VCC = 4 * MiB;
constexpr size_t WS_MISC = 5 * MiB;
constexpr size_t WS_GATES = 6 * MiB;
constexpr size_t WS_WA_IN = 16 * MiB, WS_WA_OUT = 19 * MiB, WS_WB_IN = 21 * MiB, WS_WB_OUT = 27 * MiB, WS_CW1K = 29 * MiB, WS_CW1V = 30 * MiB;
constexpr size_t WS_FFN_GU = 31 * MiB, WS_FFN_D = 45 * MiB, WS_MOE_GU = 52 * MiB, WS_MOE_D = 164 * MiB;
constexpr size_t WS_ACT = 220 * MiB;
constexpr size_t WS_XB = WS_ACT;
constexpr size_t WS_Q = WS_ACT + 64 * MiB;
constexpr size_t WS_KV = WS_ACT + 128 * MiB;
constexpr size_t KV_STRIDE_B = 16 * MiB;
constexpr size_t WS_HFF = WS_ACT;
constexpr size_t WS_X1B = WS_ACT + 224 * MiB;
constexpr size_t WS_CHID = WS_ACT + 224 * MiB;
constexpr size_t WS_X3B = WS_ACT;
constexpr size_t WS_XG = WS_ACT + 64 * MiB;
constexpr size_t WS_HMOE = WS_ACT + 196 * MiB;
constexpr size_t WS_END = WS_ACT + 308 * MiB;
static_assert(WS_MOE_D + 8 * 7 * MiB <= WS_ACT && WS_X1B + 64 * MiB <= WS_END && WS_HMOE + 112 * MiB <= WS_END && WS_XG + 132 * MiB <= WS_HMOE, "d_ws map");
constexpr int CW_CNT = 64;
constexpr int CW_BAR = 1024;

constexpr int RING_BYTES = 131072, LDSCTL_OFF = 135168, LDS_BYTES = 147456;

#define XB_TMO      128
#define XB_XCNT(j)  (256  + 64 * (j))
#define XB_XSUB(j)  (1280 + 64 * (j))
#define XB_XGEN(j)  (2304 + 64 * (j))
#define XB_TOP      3328
#define XB_TOPGEN   3392
#define XCD_BAR_WORDS 3456
#define XB_SPIN_CAP (1u << 18)
static_assert((CW_BAR + 2 * XCD_BAR_WORDS) * 4 <= (int)CTL_ZERO_BYTES, "CTL words inside the memset region");
__device__ __forceinline__ unsigned xb_ld(unsigned* p)              { return __hip_atomic_load(p, __ATOMIC_RELAXED, __HIP_MEMORY_SCOPE_AGENT); }
__device__ __forceinline__ unsigned xb_add(unsigned* p, unsigned v) { return __hip_atomic_fetch_add(p, v, __ATOMIC_RELAXED, __HIP_MEMORY_SCOPE_AGENT); }
__device__ __forceinline__ unsigned xb_xcc_id() { return (unsigned)__builtin_amdgcn_s_getreg((3 << 11) | 20) & 0xFu; }
#define XB_SPIN(cond, bar) do { unsigned _sp = 0; while (cond) { __builtin_amdgcn_s_sleep(1); \
    if ((++_sp & 255u) == 0u) { if (xb_ld(&(bar)[XB_TMO])) break; if (_sp > XB_SPIN_CAP) { atomicAdd(&(bar)[XB_TMO], 1u); break; } } } } while (0)
struct XcdBarrier { unsigned* bar; unsigned x; volatile LAS unsigned* st; };
__device__ __forceinline__ XcdBarrier xcd_barrier_post(unsigned* bar, volatile LAS unsigned* st) {
    XcdBarrier b; b.bar = bar; b.x = xb_xcc_id(); b.st = st;
    if (threadIdx.x == 0) (void)xb_add(&bar[XB_XCNT(b.x)], 1u);
    return b;
}
__device__ __forceinline__ void xcd_barrier_complete(unsigned* bar, unsigned x, unsigned& nloc, unsigned& nx) {
    const unsigned G = gridDim.x * gridDim.y * gridDim.z;
    unsigned sum, cnt, mine, sp = 0u;
    for (;;) {
        sum = 0u; cnt = 0u; mine = 0u;
#pragma unroll
        for (unsigned j = 0; j < 16; ++j) { const unsigned c = xb_ld(&bar[XB_XCNT(j)]); sum += c; cnt += (c > 0u) ? 1u : 0u; mine = (j == x) ? c : mine; }
        if (sum == G) break;
        __builtin_amdgcn_s_sleep(1);
        if ((++sp & 255u) == 0u) { if (xb_ld(&bar[XB_TMO])) break; if (sp > XB_SPIN_CAP) { atomicAdd(&bar[XB_TMO], 1u); break; } }
    }
    nloc = mine > 0u ? mine : 1u; nx = cnt > 0u ? cnt : 1u;
}
__device__ __forceinline__ void xcd_barrier(const XcdBarrier& b) {
    asm volatile("s_waitcnt vmcnt(0)" ::: "memory");
    __syncthreads();
    if (threadIdx.x == 0) {
        unsigned* bar = b.bar;
        __builtin_amdgcn_s_waitcnt(0);
        unsigned nloc = b.st[0], nx = b.st[1];
        if (nloc == 0u) { xcd_barrier_complete(bar, b.x, nloc, nx); b.st[0] = nloc; b.st[1] = nx; }
        const unsigned old = xb_add(&bar[XB_XSUB(b.x)], 1u);
        const unsigned gen = old / nloc;
        if (old + 1u == (gen + 1u) * nloc) {
            __builtin_amdgcn_fence(__ATOMIC_RELEASE, "agent");
            asm volatile("s_waitcnt vmcnt(0)" ::: "memory");
            const unsigned og = xb_add(&bar[XB_TOP], 1u);
            const unsigned tg = og / nx;
            if (og + 1u == (tg + 1u) * nx) xb_add(&bar[XB_TOPGEN], 1u);
            else XB_SPIN(xb_ld(&bar[XB_TOPGEN]) == tg, bar);
            __builtin_amdgcn_fence(__ATOMIC_ACQUIRE, "agent");
            xb_add(&bar[XB_XGEN(b.x)], 1u);
            asm volatile("s_waitcnt vmcnt(0)" ::: "memory");
        } else {
            XB_SPIN(xb_ld(&bar[XB_XGEN(b.x)]) == gen, bar);
            __builtin_amdgcn_fence(__ATOMIC_ACQUIRE, "agent");
            asm volatile("s_waitcnt vmcnt(0)" ::: "memory");
        }
    }
    __syncthreads();
}

__device__ __forceinline__ float wave_sum(float v) {
#pragma unroll
    for (int o = 1; o < 64; o <<= 1) v += __shfl_xor(v, o);
    return v;
}
__device__ __forceinline__ unsigned f2bf(float f) { unsigned u = __float_as_uint(f); return (u + 0x7fffu + ((u >> 16) & 1u)) >> 16; }
__device__ __forceinline__ unsigned pk2(float lo, float hi) { return f2bf(lo) | (f2bf(hi) << 16); }
#define LDS_WAIT() asm volatile("s_waitcnt lgkmcnt(0)" ::: "memory")

__device__ __forceinline__ int wmap(int mode, int n) {
    if (mode == 1) { const int h = n & ~63, d = n & 63; return h + (d < 32 ? 8 * (d >> 2) + (d & 3) : 8 * ((d - 32) >> 2) + 4 + (d & 3)); }
    if (mode == 2) return ((n >> 7) << 8) + (n & 127);
    if (mode == 3) return ((n >> 7) << 8) + 128 + (n & 127);
    return n;
}
__device__ __forceinline__ void transpose_item(const float* W, int K, int N, bf16_t* WT, int row_off, int mode, LAS float* scr, int item, int lane) {
    const int nblk = (N + 31) / 32, kb = item / nblk, nb = item % nblk, k0 = 64 * kb, n0 = 32 * nb;
    const int nn = n0 + (lane & 31); const bool nok = nn < N;
#pragma unroll 8
    for (int i = 0; i < 32; ++i) { const int kk = 2 * i + (lane >> 5); scr[kk * 33 + (lane & 31)] = nok ? W[(size_t)(k0 + kk) * N + nn] : 0.f; }
    LDS_WAIT(); asm volatile("" ::: "memory");
    const int c = lane & 7;
#pragma unroll
    for (int j = 0; j < 4; ++j) { const int n = (lane >> 3) + 8 * j; const LAS float* s = scr + (8 * c) * 33 + n;
        u32x4 o; o.x = pk2(s[0 * 33], s[1 * 33]); o.y = pk2(s[2 * 33], s[3 * 33]); o.z = pk2(s[4 * 33], s[5 * 33]); o.w = pk2(s[6 * 33], s[7 * 33]);
        if (n0 + n < N) *(u32x4*)(WT + (size_t)(row_off + wmap(mode, n0 + n)) * K + k0 + 8 * c) = o; }
    LDS_WAIT(); asm volatile("" ::: "memory");
}

namespace att {
constexpr float NEG_INF = -__builtin_huge_valf();
constexpr float SENT = -1e30f;
constexpr float THR = 6.f;
struct St { float mhat, l; f32x16 o0, o1; };
__device__ __forceinline__ void st_init(St& s, float m0, float l0) { s.mhat = m0; s.l = l0;
#pragma unroll
    for (int r = 0; r < 16; ++r) { s.o0[r] = 0.f; s.o1[r] = 0.f; } }
__device__ __forceinline__ float xhalf(float v) { auto rr = __builtin_amdgcn_permlane32_swap(__float_as_uint(v), __float_as_uint(v), false, false); return __uint_as_float((threadIdx.x & 32) ? rr[0] : rr[1]); }
__device__ __forceinline__ float xmax(float v) { auto rr = __builtin_amdgcn_permlane32_swap(__float_as_uint(v), __float_as_uint(v), false, false); return __builtin_amdgcn_fmed3f(__uint_as_float(rr[0]), __uint_as_float(rr[1]), -NEG_INF); }
__device__ __forceinline__ void glds16(const void* gsrc, unsigned lds_dst) { unsigned keep;
    asm volatile("s_mov_b32 %0, m0\n\ts_mov_b32 m0, %2\n\ts_nop 0\n\tglobal_load_lds_dwordx4 %1, off\n\ts_mov_b32 m0, %0" : "=&s"(keep) : "v"(gsrc), "s"(lds_dst) : "memory"); }
#define ATT_WAIT_BAR() asm volatile("s_waitcnt vmcnt(0) lgkmcnt(0)\n\ts_barrier" ::: "memory")
__device__ __forceinline__ void kv_dma(const bf16_t* Kg, const bf16_t* Vg, LAS unsigned char* Ks, LAS unsigned char* Vs, int wid, int lane) {
    glds16(Kg + lane * 64 + wid * 8, (unsigned)__builtin_amdgcn_readfirstlane((unsigned)(uintptr_t)(Ks + wid * 1024)));
    glds16(Vg + (16 * (wid & 3) + (lane >> 2)) * 64 + (wid >> 2) * 32 + (lane & 3) * 8, (unsigned)__builtin_amdgcn_readfirstlane((unsigned)(uintptr_t)(Vs + wid * 1024)));
}
__device__ __forceinline__ s16x4 vtr(const LAS unsigned char* p) { typedef short v4i16_t __attribute__((ext_vector_type(4)));
    return __builtin_bit_cast(s16x4, __builtin_amdgcn_ds_read_tr16_b64_v4i16((LAS v4i16_t*)p)); }
__device__ __forceinline__ void qkt(f32x16& p0, f32x16& p1, const LAS unsigned char* Ks, const bf16x8 (&qr)[4], const f32x16& c, int lane) {
    const LAS unsigned char* kp = Ks + (lane >> 5) * 1024 + (lane & 31) * 16;
    { const bf16x8 b0 = *(const LAS bf16x8*)(kp), b1 = *(const LAS bf16x8*)(kp + 512);
      p0 = __builtin_amdgcn_mfma_f32_32x32x16_bf16(b0, qr[0], c, 0, 0, 0); p1 = __builtin_amdgcn_mfma_f32_32x32x16_bf16(b1, qr[0], c, 0, 0, 0); }
#pragma unroll
    for (int d0 = 1; d0 < 4; ++d0) {
        const bf16x8 b0 = *(const LAS bf16x8*)(kp + d0 * 2048), b1 = *(const LAS bf16x8*)(kp + d0 * 2048 + 512);
        p0 = __builtin_amdgcn_mfma_f32_32x32x16_bf16(b0, qr[d0], p0, 0, 0, 0);
        p1 = __builtin_amdgcn_mfma_f32_32x32x16_bf16(b1, qr[d0], p1, 0, 0, 0);
    }
}
__device__ __forceinline__ void kmask(f32x16& p0, f32x16& p1, int lo_c, int hi_c, int lane) {
    const int base = 4 * (lane >> 5) - lo_c; const unsigned span = (unsigned)(hi_c - lo_c);
#pragma unroll
    for (int r = 0; r < 16; ++r) { const int kv = (r & 3) + 8 * (r >> 2);
        if ((unsigned)(kv + base) > span) p0[r] = NEG_INF;
        if ((unsigned)(kv + 32 + base) > span) p1[r] = NEG_INF; }
}
__device__ __forceinline__ void pv(f32x16& o0, f32x16& o1, const f32x16& p0, const f32x16& p1, const LAS unsigned char* Vs, int lane) {
    const LAS unsigned char* vp = Vs + ((lane >> 4) & 1) * 32 + (lane & 3) * 8 + (4 * (lane >> 5) + ((lane & 15) >> 2)) * 64;
    u32x4 pw[4];
#pragma unroll
    for (int i = 0; i < 4; ++i) { pw[0][i] = cvt_pk_bf16(p0[2 * i], p0[2 * i + 1]); pw[1][i] = cvt_pk_bf16(p0[8 + 2 * i], p0[9 + 2 * i]);
                                  pw[2][i] = cvt_pk_bf16(p1[2 * i], p1[2 * i + 1]); pw[3][i] = cvt_pk_bf16(p1[8 + 2 * i], p1[9 + 2 * i]); }
#pragma unroll
    for (int s = 0; s < 4; ++s) {
        const s16x4 l0 = vtr(vp + s * 1024), h0 = vtr(vp + s * 1024 + 512), l1 = vtr(vp + 4096 + s * 1024), h1 = vtr(vp + 4096 + s * 1024 + 512);
        const bf16x8 v0 = (bf16x8){l0[0], l0[1], l0[2], l0[3], h0[0], h0[1], h0[2], h0[3]}, v1 = (bf16x8){l1[0], l1[1], l1[2], l1[3], h1[0], h1[1], h1[2], h1[3]};
        const bf16x8 pa = __builtin_bit_cast(bf16x8, pw[s]);
        o0 = __builtin_amdgcn_mfma_f32_32x32x16_bf16(v0, pa, o0, 0, 0, 0);
        o1 = __builtin_amdgcn_mfma_f32_32x32x16_bf16(v1, pa, o1, 0, 0, 0);
    }
}
__device__ __forceinline__ float rowmax(const f32x16& p0, const f32x16& p1) {
    float a = __builtin_amdgcn_fmed3f(p0[0], p1[0], -NEG_INF), b = __builtin_amdgcn_fmed3f(p0[1], p1[1], -NEG_INF);
#pragma unroll
    for (int r = 2; r < 16; r += 2) { a = __builtin_amdgcn_fmed3f(a, p0[r], -NEG_INF); b = __builtin_amdgcn_fmed3f(b, p0[r + 1], -NEG_INF); a = __builtin_amdgcn_fmed3f(a, p1[r], -NEG_INF); b = __builtin_amdgcn_fmed3f(b, p1[r + 1], -NEG_INF); }
    return xmax(__builtin_amdgcn_fmed3f(a, b, -NEG_INF));
}
template <bool MASK, bool PV>
__device__ __forceinline__ void block(const LAS unsigned char* Ks, const LAS unsigned char* Vs, const bf16x8 (&qr)[4], St& st, int lo_c, int hi_c, bool on, int lane) {
    f32x16 p0, p1;
    { f32x16 c; const float cm = on ? ((st.mhat == SENT) ? 0.f : -st.mhat) : NEG_INF;
#pragma unroll
        for (int r = 0; r < 16; ++r) c[r] = cm;
        qkt(p0, p1, Ks, qr, c, lane); }
    if (MASK) kmask(p0, p1, lo_c, hi_c, lane);
    const float rm = rowmax(p0, p1);
    const bool fresh = st.mhat == SENT, need = fresh ? (rm > NEG_INF) : (rm > THR);
    if (__any(need)) {
        const float dl = need ? rm : 0.f, f = (need && !fresh) ? __builtin_amdgcn_exp2f(-dl) : 1.f;
        st.mhat = need ? (fresh ? dl : st.mhat + dl) : st.mhat;
#pragma unroll
        for (int r = 0; r < 16; ++r) { p0[r] -= dl; p1[r] -= dl; }
        st.l *= f;
        if (PV) {
#pragma unroll
            for (int r = 0; r < 16; ++r) { st.o0[r] *= f; st.o1[r] *= f; } }
    }
    float sa = 0.f, sb = 0.f;
#pragma unroll
    for (int r = 0; r < 16; ++r) { p0[r] = __builtin_amdgcn_exp2f(p0[r]); p1[r] = __builtin_amdgcn_exp2f(p1[r]); sa += p0[r]; sb += p1[r]; }
    st.l += sa + sb;
    if (PV) pv(st.o0, st.o1, p0, p1, Vs, lane);
}
template <bool PV>
__device__ __forceinline__ void block_any(const LAS unsigned char* Ks, const LAS unsigned char* Vs, const bf16x8 (&qr)[4], St& st, int lo_rel, int hi_rel, bool extra_on, int lane) {
    const bool on = extra_on && hi_rel >= 0 && lo_rel <= 63;
    if (!__any(on)) return;
    const int lo_c = lo_rel < 0 ? 0 : lo_rel, hi_c = hi_rel > 63 ? 63 : hi_rel;
    if (__any(on && (lo_c > 0 || hi_c < 63))) block<true, PV>(Ks, Vs, qr, st, lo_c, hi_c, on, lane);
    else block<false, PV>(Ks, Vs, qr, st, 0, 63, on, lane);
}
__device__ __forceinline__ void load_q(bf16x8 (&qr)[4], const bf16_t* Qrow  , int lane) {
#pragma unroll
    for (int d0 = 0; d0 < 4; ++d0) qr[d0] = *(const bf16x8*)(Qrow + d0 * 16 + (lane >> 5) * 8);
}
__device__ __forceinline__ void fold(f32x16& a0, f32x16& a1, const St& st, float w) {
    const float lt = st.l + xhalf(st.l), sc = lt > 0.f ? w / lt : 0.f;
#pragma unroll
    for (int r = 0; r < 16; ++r) { a0[r] += sc * st.o0[r]; a1[r] += sc * st.o1[r]; }
}
__device__ __forceinline__ void store_o(bf16_t* Orow, const f32x16& a0, const f32x16& a1, int lane) {
    const int hi = lane >> 5;
#pragma unroll
    for (int r = 0; r < 16; r += 2) { const int d = (r & 3) + 8 * (r >> 2) + 4 * hi;
        *(unsigned*)(Orow + d) = cvt_pk_bf16(a0[r], a0[r + 1]); *(unsigned*)(Orow + 32 + d) = cvt_pk_bf16(a1[r], a1[r + 1]); }
}
}

__device__ __forceinline__ void swa_unit(LAS unsigned char* lds, int b, int kvh, int tile, const bf16_t* Q, const bf16_t* Kh, const bf16_t* Vh, bf16_t* O, const float* sinks) {
    int tid = threadIdx.x; asm volatile("" : "+v"(tid));
    const int lane = tid & 63, wid = __builtin_amdgcn_readfirstlane(tid >> 6), g = wid & 3, s = wid >> 2, r32 = lane & 31;
    const bf16_t* Kb = Kh + (size_t)(b * NKV + kvh) * SEQ * HD; const bf16_t* Vb = Vh + (size_t)(b * NKV + kvh) * SEQ * HD;
#pragma unroll
    for (int i = 0; i < 3; ++i) { const int j = tile - 2 + i; if (j >= 0) att::kv_dma(Kb + (size_t)j * 64 * HD, Vb + (size_t)j * 64 * HD, lds + i * 8192, lds + 24576 + i * 8192, wid, lane); }
    const int t = tile * 64 + s * 32 + r32, head = kvh * 4 + g;
    const size_t qoff = ((size_t)b * SEQ + t) * DM + head * HD;
    bf16x8 qr[4]; att::load_q(qr, Q + qoff, lane);
    const float sink = sinks[head];
    ATT_WAIT_BAR();
    att::St st; att::st_init(st, sink * LOG2E, (lane < 32) ? 1.f : 0.f);
#pragma unroll
    for (int i = 0; i < 3; ++i) { const int j = tile - 2 + i;
        if (j >= 0) att::block_any<true>(lds + i * 8192, lds + 24576 + i * 8192, qr, st, t - 127 - 64 * j, t - 64 * j, true, lane); }
    f32x16 a0, a1;
#pragma unroll
    for (int r = 0; r < 16; ++r) { a0[r] = 0.f; a1[r] = 0.f; }
    att::fold(a0, a1, st, 1.f);
    att::store_o(O + qoff, a0, a1, lane);
    ATT_WAIT_BAR();
}

static_assert(65536 + 4 * 64 * 65 * 4 <= LDSCTL_OFF, "NSA importance table below the LDS control words");
constexpr int NSA_IMP = 65536, NSA_IMPF = 0, NSA_SELM = 16640, NSA_SELU = 17152, NSA_KS = 32768;
struct NsaT { const bf16_t* Q; bf16_t* O; const bf16_t *KS, *VS, *KW, *VW, *KCC, *VCC; const float* gates; };
__device__ __forceinline__ void nsa_unit(LAS unsigned char* lds, int b, int kvh, int tile, const NsaT& T) {
    int tid = threadIdx.x; asm volatile("" : "+v"(tid));
    const int lane = tid & 63, wid = __builtin_amdgcn_readfirstlane(tid >> 6), g = wid & 3, s = wid >> 2, r32 = lane & 31, hi = lane >> 5;
    const int t = tile * 64 + s * 32 + r32, head = kvh * 4 + g, cur = tile;
    const size_t qoff = ((size_t)b * SEQ + t) * DM + head * HD;
    const size_t bh = (size_t)(b * NKV + kvh);
    {
        const bf16_t* Kc = T.KCC + bh * 256 * HD; const bf16_t* Vc = T.VCC + bh * 256 * HD;
#pragma unroll
        for (int i = 0; i < 4; ++i) att::kv_dma(Kc + i * 64 * HD, Vc + i * 64 * HD, lds + i * 8192, lds + 32768 + i * 8192, wid, lane);
    }
    bf16x8 qr[4]; att::load_q(qr, T.Q + qoff, lane);
    const float* gp = T.gates + ((size_t)b * SEQ + t) * 48 + head * 3;
    const float g_c = gp[0], g_s = gp[1], g_w = gp[2];
    ATT_WAIT_BAR();
    f32x16 a0, a1;
#pragma unroll
    for (int r = 0; r < 16; ++r) { a0[r] = 0.f; a1[r] = 0.f; }
    const int iv = (t - 31) >> 4;
    {
        att::St st; att::st_init(st, att::SENT, 0.f);
#pragma unroll 1
        for (int blk = 0; blk < 4; ++blk) att::block_any<false>(lds + blk * 8192, lds + 32768 + blk * 8192, qr, st, 0, iv - 64 * blk, true, lane);
        const float lt = st.l + att::xhalf(st.l), inv_l = lt > 0.f ? 1.f / lt : 0.f, mfin = st.mhat;
        f32x16 c0, c1;
#pragma unroll
        for (int r = 0; r < 16; ++r) { c0[r] = 0.f; c1[r] = 0.f; }
        int r32o = r32; asm volatile("" : "+v"(r32o));
        LAS float* imp_row = (LAS float*)(lds + NSA_IMP) + (g * 64 + s * 32 + r32o) * 65;
        float prevx = 0.f;
#pragma unroll 1
        for (int blk = 0; blk < 4; ++blk) {
            const int hi_rel = iv - 64 * blk; const bool on = hi_rel >= 0;
            if (!__any(on)) {
#pragma unroll
                for (int k = 0; k < 8; ++k) imp_row[16 * blk + 2 * k + hi] = 0.f;
                prevx = 0.f; continue;
            }
            f32x16 p0, p1, cinit; const float cm = on ? -mfin : att::NEG_INF;
#pragma unroll
            for (int r = 0; r < 16; ++r) cinit[r] = cm;
            att::qkt(p0, p1, lds + blk * 8192, qr, cinit, lane);
            att::kmask(p0, p1, 0, hi_rel > 63 ? 63 : hi_rel, lane);
#pragma unroll
            for (int r = 0; r < 16; ++r) { p0[r] = __builtin_amdgcn_exp2f(p0[r]) * inv_l; p1[r] = __builtin_amdgcn_exp2f(p1[r]) * inv_l; }
#pragma unroll
            for (int tt = 0; tt < 2; ++tt)
#pragma unroll
                for (int r2 = 0; r2 < 4; ++r2) {
                    const float pa = tt ? p1[4 * r2] : p0[4 * r2], pb = tt ? p1[4 * r2 + 1] : p0[4 * r2 + 1], pc = tt ? p1[4 * r2 + 2] : p0[4 * r2 + 2], pd = tt ? p1[4 * r2 + 3] : p0[4 * r2 + 3];
                    float own = 2.f * (pa + pb + pc) + pd; const float other = att::xhalf(pd);
                    if (hi) own += other; else { own += prevx; prevx = other; }
                    imp_row[16 * blk + 8 * tt + 2 * r2 + hi] = own;
                }
            att::pv(c0, c1, p0, p1, lds + 32768 + blk * 8192, lane);
        }
#pragma unroll
        for (int r = 0; r < 16; ++r) { a0[r] = g_c * c0[r]; a1[r] = g_c * c1[r]; }
    }
    __syncthreads();
    {
        int tid2 = tid; asm volatile("" : "+v"(tid2));
        const int tok = tid2 >> 3, seg = tid2 & 7; const LAS float* ip = (const LAS float*)(lds + NSA_IMP); LAS float* impf = (LAS float*)(lds + NSA_IMPF);
        float v[8];
#pragma unroll
        for (int i = 0; i < 8; ++i) { const int j = 8 * seg + i;
            float x = (ip[(0 * 64 + tok) * 65 + j] + ip[(1 * 64 + tok) * 65 + j]) + (ip[(2 * 64 + tok) * 65 + j] + ip[(3 * 64 + tok) * 65 + j]);
            if (j == 0 || j == cur || j == cur - 1) x = 1e4f;
            if (j > cur) x = -1.f;
            v[i] = x; }
        if (tid < 2) ((LAS unsigned*)(lds + NSA_SELU))[tid] = 0u;
#pragma unroll
        for (int i = 0; i < 8; ++i) impf[tok * 65 + 8 * seg + i] = v[i];
        __syncthreads();
        int rank[8];
#pragma unroll
        for (int i = 0; i < 8; ++i) rank[i] = 0;
        for (int k = 0; k < 64; ++k) { const float x = impf[tok * 65 + k];
#pragma unroll
            for (int i = 0; i < 8; ++i) rank[i] += (x > v[i] || (x == v[i] && k < 8 * seg + i)) ? 1 : 0; }
        unsigned bits = 0;
#pragma unroll
        for (int i = 0; i < 8; ++i) bits |= (rank[i] < 16 ? 1u : 0u) << i;
        unsigned mlo = seg < 4 ? bits << (8 * seg) : 0u, mhi = seg >= 4 ? bits << (8 * (seg - 4)) : 0u;
#pragma unroll
        for (int o = 1; o < 8; o <<= 1) { mlo |= __shfl_xor(mlo, o); mhi |= __shfl_xor(mhi, o); }
        if (seg == 0) { LAS unsigned* sm = (LAS unsigned*)(lds + NSA_SELM); sm[2 * tok] = mlo; sm[2 * tok + 1] = mhi; }
        unsigned ulo = mlo, uhi = mhi;
#pragma unroll
        for (int o = 8; o < 64; o <<= 1) { ulo |= __shfl_xor(ulo, o); uhi |= __shfl_xor(uhi, o); }
        if (lane == 0) { __hip_atomic_fetch_or((LAS unsigned*)(lds + NSA_SELU), ulo, __ATOMIC_RELAXED, __HIP_MEMORY_SCOPE_WORKGROUP); __hip_atomic_fetch_or((LAS unsigned*)(lds + NSA_SELU) + 1, uhi, __ATOMIC_RELAXED, __HIP_MEMORY_SCOPE_WORKGROUP); }
        __syncthreads();
    }
    {
        int r32o = r32; asm volatile("" : "+v"(r32o));
        const LAS unsigned* sm = (const LAS unsigned*)(lds + NSA_SELM);
        const unsigned mlo = sm[2 * (s * 32 + r32o)], mhi = sm[2 * (s * 32 + r32o) + 1];
        const unsigned ulo = __builtin_amdgcn_readfirstlane(((const LAS unsigned*)(lds + NSA_SELU))[0]), uhi = __builtin_amdgcn_readfirstlane(((const LAS unsigned*)(lds + NSA_SELU))[1]);
        unsigned long long U = ((unsigned long long)uhi << 32) | ulo;
        if (cur < 63) U &= (1ull << (cur + 1)) - 1ull;
        U |= 1ull;
        const int wlo = cur - 8 < 0 ? 0 : cur - 8;
        const bf16_t* KSb = T.KS + bh * SEQ * HD; const bf16_t* VSb = T.VS + bh * SEQ * HD; const bf16_t* KWb = T.KW + bh * SEQ * HD; const bf16_t* VWb = T.VW + bh * SEQ * HD;
#define NSA_NEXT(it) (((it) < 64) ? ((((it) >= 63) ? 0ull : (U & ~((2ull << (it)) - 1ull))) != 0ull ? (int)__builtin_ctzll(U & ~((2ull << ((it) & 63)) - 1ull)) : 64 + wlo) : (((it) - 64 < cur) ? (it) + 1 : -1))
#define NSA_DMA(it, sl) do { const int _j = (it) & 63; const bool _w = (it) >= 64; \
        att::kv_dma((_w ? KWb : KSb) + (size_t)_j * 64 * HD, (_w ? VWb : VSb) + (size_t)_j * 64 * HD, lds + NSA_KS + (sl) * 16384, lds + NSA_KS + (sl) * 16384 + 8192, wid, lane); } while (0)
        att::St st; att::st_init(st, att::SENT, 0.f);
        int it = 0, jl = 0, q1, q2, q3, sl = 0; bool in_win = false;
        NSA_DMA(0, 0);
        q1 = NSA_NEXT(0);  NSA_DMA(q1 >= 0 ? q1 : jl, 1); if (q1 >= 0) jl = q1;
        q2 = q1 >= 0 ? NSA_NEXT(q1) : -1; NSA_DMA(q2 >= 0 ? q2 : jl, 2); if (q2 >= 0) jl = q2;
        asm volatile("s_waitcnt vmcnt(4) lgkmcnt(0)\n\ts_barrier" ::: "memory");
        for (;;) {
            q3 = q2 >= 0 ? NSA_NEXT(q2) : -1; NSA_DMA(q3 >= 0 ? q3 : jl, (sl + 3) & 3); if (q3 >= 0) jl = q3;
            const LAS unsigned char* Ks = lds + NSA_KS + sl * 16384; const LAS unsigned char* Vs = Ks + 8192;
            {
                const bool w = it >= 64; const int j = it & 63;
                if (w && !in_win) { att::fold(a0, a1, st, g_s); att::st_init(st, att::SENT, 0.f); in_win = true; }
                const bool sel = ((j < 32 ? (mlo >> j) : (mhi >> (j - 32))) & 1u) != 0u;
                att::block_any<true>(Ks, Vs, qr, st, w ? t - 511 - 64 * j : 0, t - 64 * j, w || sel, lane);
            }
            asm volatile("s_waitcnt vmcnt(4) lgkmcnt(0)\n\ts_barrier" ::: "memory");
            if (q1 < 0) break;
            it = q1; q1 = q2; q2 = q3; sl = (sl + 1) & 3;
        }
        att::fold(a0, a1, st, g_w);
        ATT_WAIT_BAR();
#undef NSA_NEXT
#undef NSA_DMA
    }
    att::store_o(T.O + qoff, a0, a1, lane);
}

__device__ __forceinline__ void ln_apply(f32x4 (&v)[4], const float* gain, const float* bias, int lane) {
    float s = 0.f;
#pragma unroll
    for (int j = 0; j < 4; ++j) s += (v[j][0] + v[j][1]) + (v[j][2] + v[j][3]);
    const float mean = wave_sum(s) * (1.f / DM); float s2 = 0.f;
#pragma unroll
    for (int j = 0; j < 4; ++j) { v[j] = v[j] - mean; s2 += (v[j][0] * v[j][0] + v[j][1] * v[j][1]) + (v[j][2] * v[j][2] + v[j][3] * v[j][3]); }
    const float rstd = 1.f / sqrtf(wave_sum(s2) * (1.f / DM) + LN_EPS);
#pragma unroll
    for (int j = 0; j < 4; ++j) { const f32x4 gg = *(const f32x4*)(gain + 4 * lane + 256 * j), bb = *(const f32x4*)(bias + 4 * lane + 256 * j); v[j] = v[j] * rstd * gg + bb; }
}
__device__ __forceinline__ void store_row_bf16(bf16_t* orow, const f32x4 (&v)[4], int lane) {
#pragma unroll
    for (int j = 0; j < 4; ++j) { u32x2 w; w.x = cvt_pk_bf16(v[j][0], v[j][1]); w.y = cvt_pk_bf16(v[j][2], v[j][3]); *(u32x2*)(orow + 4 * lane + 256 * j) = w; }
}
__device__ __forceinline__ void load_row_bf16(f32x4 (&v)[4], const bf16_t* row, int lane) {
#pragma unroll
    for (int j = 0; j < 4; ++j) { const u32x2 w = *(const u32x2*)(row + 4 * lane + 256 * j); v[j][0] = bf_lo(w.x); v[j][1] = bf_hi(w.x); v[j][2] = bf_lo(w.y); v[j][3] = bf_hi(w.y); }
}
__device__ __forceinline__ void moe_offsets(unsigned* ctl, int (&toff)[9]) {
    int acc = 0;
#pragma unroll
    for (int e = 0; e < 8; ++e) { toff[e] = acc; const int c = (int)__builtin_amdgcn_readfirstlane(__hip_atomic_load(ctl + CW_CNT + 64 * e, __ATOMIC_RELAXED, __HIP_MEMORY_SCOPE_AGENT)); acc += (c + 255) >> 8; }
    toff[8] = acc;
}
struct BOffMoe { int t1, t2, t3, t4, t5, t6, t7; size_t estride, tstride;
    __device__ __forceinline__ size_t operator()(const pg8::Unit& u) const {
        const int pm = u.pm; const int e = (pm >= t1) + (pm >= t2) + (pm >= t3) + (pm >= t4) + (pm >= t5) + (pm >= t6) + (pm >= t7);
        return (size_t)e * estride + (size_t)u.pn * tstride; } };
struct BOffCmp { __device__ __forceinline__ size_t operator()(const pg8::Unit& u) const { return (u.pm >= 32) ? (size_t)MiB : (size_t)0; } };
struct EpiCmp {
    static constexpr bool PERM = true;
    bf16_t* O; const float* bias;
    __device__ __forceinline__ void operator()(const f32x4 (&acc)[2][2][4][2], const pg8::Unit& u, int wr, int wc, int fr, int fq) const {
        pg8::EpiBf16<1> e{O, 256, bias + ((u.pm >= 32) ? 256 : 0)}; e(acc, u, wr, wc, fr, fq);
    }
};

__device__ const double ROPE_INV[32] = {1.0, 0.7498942093324559, 0.5623413251903491, 0.4216965034285822, 0.31622776601683794, 0.23713737056616552, 0.1778279410038923, 0.1333521432163324,
    0.1, 0.07498942093324558, 0.05623413251903491, 0.042169650342858224, 0.03162277660168379, 0.023713737056616554, 0.01778279410038923, 0.01333521432163324,
    0.01, 0.007498942093324558, 0.005623413251903491, 0.004216965034285823, 0.0031622776601683794, 0.0023713737056616554, 0.0017782794100389228, 0.001333521432163324,
    0.001, 0.0007498942093324559, 0.0005623413251903491, 0.00042169650342858224, 0.00031622776601683794, 0.00023713737056616554, 0.00017782794100389227, 0.0001333521432163324};

constexpr int NPH = 26;
struct Args { const float* in[21]; float* out; unsigned char* ws; int ph_lo, ph_hi, li, pad; };
enum { I_X = 0, I_AWIN, I_AWOUT, I_ASINK, I_BWIN, I_BWOUT, I_POSK, I_POSV, I_CKW1, I_CKW2, I_CVW1, I_CVW2, I_FG, I_FU, I_FD, I_ROUTER, I_MG, I_MU, I_MD, I_LNG, I_LNB };

__global__ void __launch_bounds__(512, 2) fwd(Args args) {
    extern __shared__ __attribute__((aligned(16))) unsigned char lds_raw[];
    LAS unsigned char* lds = (LAS unsigned char*)lds_raw;
    const int tid = threadIdx.x, lane = tid & 63, wave = __builtin_amdgcn_readfirstlane(tid >> 6);
    const int G = gridDim.x, wg = blockIdx.x, gw = wg * 8 + wave, NGW = G * 8;
    unsigned char* ws = args.ws;
    unsigned* ctl = (unsigned*)(ws + WS_CTL);
    const int lo = args.ph_lo, hi = args.ph_hi;
    volatile LAS unsigned* MISC = (volatile LAS unsigned*)(lds + LDSCTL_OFF);
    if (tid < 64) MISC[tid] = 0u;
    __syncthreads();
    XcdBarrier bar; bar.bar = ctl + CW_BAR + args.li * XCD_BAR_WORDS; bar.x = 0; bar.st = MISC + 8;
    if (hi - lo > 1) bar = xcd_barrier_post(ctl + CW_BAR + args.li * XCD_BAR_WORDS, MISC + 8);
#ifndef PHMASK
#define PHMASK 0xFFFFFFFFu
#endif
#define IN(k) (((PHMASK >> (k)) & 1u) && lo <= (k) && (k) < hi)
#define SEAM(k) do { if (IN(k) && IN((k) + 1)) xcd_barrier(bar); } while (0)
    bf16_t* const WA_IN = (bf16_t*)(ws + WS_WA_IN); bf16_t* const WA_OUT = (bf16_t*)(ws + WS_WA_OUT); bf16_t* const WB_IN = (bf16_t*)(ws + WS_WB_IN); bf16_t* const WB_OUT = (bf16_t*)(ws + WS_WB_OUT);
    bf16_t* const CW1 = (bf16_t*)(ws + WS_CW1K); bf16_t* const FFN_GU = (bf16_t*)(ws + WS_FFN_GU); bf16_t* const FFN_D = (bf16_t*)(ws + WS_FFN_D);
    bf16_t* const MOE_GU = (bf16_t*)(ws + WS_MOE_GU); bf16_t* const MOE_D = (bf16_t*)(ws + WS_MOE_D);
    float* const ROPE = (float*)(ws + WS_ROPE); float* const POSB = (float*)(ws + WS_MISC); bf16_t* const W2T = (bf16_t*)(ws + WS_MISC + 4096);
    float* const GATES = (float*)(ws + WS_GATES); bf16_t* const KCC = (bf16_t*)(ws + WS_KCC);
    bf16_t* const XB = (bf16_t*)(ws + WS_XB); bf16_t* const QB = (bf16_t*)(ws + WS_Q); bf16_t* const KVB = (bf16_t*)(ws + WS_KV);
    bf16_t* const HFF = (bf16_t*)(ws + WS_HFF); bf16_t* const X1B = (bf16_t*)(ws + WS_X1B); bf16_t* const CHID = (bf16_t*)(ws + WS_CHID);
    bf16_t* const X3B = (bf16_t*)(ws + WS_X3B); bf16_t* const XG = (bf16_t*)(ws + WS_XG); bf16_t* const HMOE = (bf16_t*)(ws + WS_HMOE);
    int* const ROUTE = (int*)(ws + WS_ROUTE);
    bf16_t* const Y16 = (bf16_t*)args.out;
    bf16_t* const OB0 = KVB + 2 * (KV_STRIDE_B / 2);
    constexpr size_t KVS = KV_STRIDE_B / 2;

    if (IN(0)) {
        LAS float* scr = (LAS float*)(lds + wave * 16384);
        constexpr int I_A1 = 16 * 48, I_A2 = 16 * 32, I_B1 = 16 * 82, I_B2 = 16 * 32, I_C1 = 32 * 8, I_C2 = 4 * 2, I_F = 16 * 112, I_FDN = 56 * 32, I_ME = 2 * I_F + I_FDN;
        constexpr int NITEMS = I_A1 + I_A2 + I_B1 + I_B2 + 2 * I_C1 + 2 * I_C2 + 2 * I_F + I_FDN + 8 * I_ME;
        for (int it = gw; it < NITEMS; it += NGW) {
            int r = it;
            if (r < I_A1) { const int n0 = 32 * (r % 48); transpose_item(args.in[I_AWIN], 1024, 1536, WA_IN, 0, n0 < 1280 ? 1 : 0, scr, r, lane); continue; } r -= I_A1;
            if (r < I_A2) { transpose_item(args.in[I_AWOUT], 1024, 1024, WA_OUT, 0, 0, scr, r, lane); continue; } r -= I_A2;
            if (r < I_B1) { const int n0 = 32 * (r % 82); const bool rp = n0 < 1280 || (n0 >= 1536 && n0 < 1792) || (n0 >= 2048 && n0 < 2304);
                transpose_item(args.in[I_BWIN], 1024, NSA_IN, WB_IN, 0, rp ? 1 : 0, scr, r, lane); continue; } r -= I_B1;
            if (r < I_B2) { transpose_item(args.in[I_BWOUT], 1024, 1024, WB_OUT, 0, 0, scr, r, lane); continue; } r -= I_B2;
            if (r < I_C1) { transpose_item(args.in[I_CKW1], 2048, 256, CW1, 0, 0, scr, r, lane); continue; } r -= I_C1;
            if (r < I_C1) { transpose_item(args.in[I_CVW1], 2048, 256, CW1, 256, 0, scr, r, lane); continue; } r -= I_C1;
            if (r < I_C2) { transpose_item(args.in[I_CKW2], 256, 64, W2T, 0, 1, scr, r, lane);     continue; } r -= I_C2;
            if (r < I_C2) { transpose_item(args.in[I_CVW2], 256, 64, W2T, 64, 0, scr, r, lane); continue; } r -= I_C2;
            if (r < I_F) { transpose_item(args.in[I_FG], 1024, DFF, FFN_GU, 0, 2, scr, r, lane); continue; } r -= I_F;
            if (r < I_F) { transpose_item(args.in[I_FU], 1024, DFF, FFN_GU, 0, 3, scr, r, lane); continue; } r -= I_F;
            if (r < I_FDN) { transpose_item(args.in[I_FD], DFF, 1024, FFN_D, 0, 0, scr, r, lane); continue; } r -= I_FDN;
            const int e = r / I_ME; r -= e * I_ME;
            if (r < I_F) { transpose_item(args.in[I_MG] + (size_t)e * 1024 * DFF, 1024, DFF, MOE_GU + (size_t)e * 2 * DFF * 1024, 0, 2, scr, r, lane); continue; } r -= I_F;
            if (r < I_F) { transpose_item(args.in[I_MU] + (size_t)e * 1024 * DFF, 1024, DFF, MOE_GU + (size_t)e * 2 * DFF * 1024, 0, 3, scr, r, lane); continue; } r -= I_F;
            transpose_item(args.in[I_MD] + (size_t)e * DFF * 1024, DFF, 1024, MOE_D + (size_t)e * 1024 * DFF, 0, 0, scr, r, lane);
        }
        for (int m = gw; m < TTOK; m += NGW) {
            f32x4 v[4];
#pragma unroll
            for (int j = 0; j < 4; ++j) v[j] = *(const f32x4*)(args.in[I_X] + (size_t)m * DM + 4 * lane + 256 * j);
            store_row_bf16(XB + (size_t)m * DM, v, lane);
        }
        for (int i = wg * 512 + tid; i < SEQ * 32; i += G * 512) {
            const int t = i >> 5, f = i & 31; const double rev = (double)t * ROPE_INV[f] * 0.15915494309189535; const float fr = (float)(rev - __builtin_rint(rev));
            ROPE[t * 64 + f] = __builtin_amdgcn_cosf(fr); ROPE[t * 64 + 32 + f] = __builtin_amdgcn_sinf(fr);
        }
        for (int o = gw; o < 512; o += NGW) {
            const float* pos = args.in[o < 256 ? I_POSK : I_POSV]; const float* w1 = args.in[o < 256 ? I_CKW1 : I_CVW1]; const int n = o & 255; float s = 0.f;
            for (int k = lane; k < 2048; k += 64) s += pos[k] * w1[(size_t)k * 256 + n];
            s = wave_sum(s); if (lane == 0) POSB[o] = s;
        }
        for (int i = wg * 512 + tid; i < (NSA_IN_PAD - NSA_IN) * 1024 / 8; i += G * 512) *(u32x4*)(WB_IN + (size_t)NSA_IN * 1024 + (size_t)i * 8) = (u32x4){0u, 0u, 0u, 0u};
    }
    SEAM(0);
    if (IN(1)) {
        pg8::Gemm g{XB, WA_IN, 1024, 1024}; pg8::StaticOrder S; S.init(128, 6, G, wg, 0);
        pg8::EpiProj E{QB, KVB, KVS, nullptr, ROPE, 1, -1, 0};
        pg8::gemm_phase(lds, g, S, E, pg8::BOffPlain{1024});
    }
    SEAM(1);
    if (IN(2)) {
        for (int u = wg; u < 2048; u += G) { const int bk = u & 31; swa_unit(lds, bk >> 2, bk & 3, u >> 5, QB, KVB, KVB + KVS, OB0, args.in[I_ASINK]); }
    }
    SEAM(2);
    if (IN(3)) {
        pg8::Gemm g{OB0, WA_OUT, 1024, 1024}; pg8::StaticOrder S; S.init(128, 4, G, wg, 0);
        pg8::EpiResid E{Y16, XB};
        pg8::gemm_phase(lds, g, S, E, pg8::BOffPlain{1024});
    }
    SEAM(3);
    if (IN(4)) {
        for (int m = gw; m < TTOK; m += NGW) { f32x4 v[4]; load_row_bf16(v, Y16 + (size_t)m * DM, lane);
            ln_apply(v, args.in[I_LNG], args.in[I_LNB], lane); store_row_bf16(X1B + (size_t)m * DM, v, lane); }
    }
    SEAM(4);
    if (IN(5)) {
        pg8::Gemm g{X1B, FFN_GU, 1024, 1024}; pg8::StaticOrder S; S.init(128, 28, G, wg, 0);
        pg8::EpiSwiglu E{HFF, DFF, 0};
        pg8::gemm_phase(lds, g, S, E, pg8::BOffPlain{1024});
    }
    SEAM(5);
    if (IN(6)) {
        pg8::Gemm g{HFF, FFN_D, DFF, DFF}; pg8::StaticOrder S; S.init(128, 4, G, wg, 0);
        pg8::EpiResid E{Y16, X1B};
        pg8::gemm_phase(lds, g, S, E, pg8::BOffPlain{DFF});
    }
    SEAM(6);
    if (IN(7)) {
        for (int m = gw; m < TTOK; m += NGW) { f32x4 v[4]; load_row_bf16(v, Y16 + (size_t)m * DM, lane);
            ln_apply(v, args.in[I_LNG] + 1024, args.in[I_LNB] + 1024, lane); store_row_bf16(XB + (size_t)m * DM, v, lane); }
    }
    SEAM(7);
    if (IN(8)) {
        pg8::Gemm g{XB, WB_IN, 1024, 1024}; pg8::StaticOrder S; S.init(128, 11, G, wg, 0);
        pg8::EpiProj E{QB, KVB, KVS, GATES, ROPE, 0x15, 10, 1};
        pg8::gemm_phase(lds, g, S, E, pg8::BOffPlain{1024});
    }
    SEAM(8);
    if (IN(9)) {
        pg8::Gemm g{KVB, CW1, 1024, 2048}; pg8::StaticOrder S; S.init(64, 1, G, wg, 0);
        EpiCmp E{CHID, POSB};
        pg8::gemm_phase(lds, g, S, E, BOffCmp{});
    }
    SEAM(9);
    if (IN(10)) {
        const int r32 = lane & 31, hh = lane >> 5;
        for (int task = gw; task < 512; task += NGW) {
            const int row0 = task * 32, which = row0 >> 13; const bf16_t* Hrow = CHID + (size_t)(row0 + r32) * 256; const bf16_t* Wt = W2T + which * 64 * 256;
            f32x16 c0, c1;
#pragma unroll
            for (int r = 0; r < 16; ++r) { c0[r] = 0.f; c1[r] = 0.f; }
#pragma unroll
            for (int ks = 0; ks < 16; ++ks) { const bf16x8 a = *(const bf16x8*)(Hrow + ks * 16 + hh * 8), b0 = *(const bf16x8*)(Wt + r32 * 256 + ks * 16 + hh * 8), b1 = *(const bf16x8*)(Wt + (32 + r32) * 256 + ks * 16 + hh * 8);
                c0 = __builtin_amdgcn_mfma_f32_32x32x16_bf16(a, b0, c0, 0, 0, 0); c1 = __builtin_amdgcn_mfma_f32_32x32x16_bf16(a, b1, c1, 0, 0, 0); }
#pragma unroll
            for (int r = 0; r < 16; ++r) { const int grow = row0 + (r & 3) + 8 * (r >> 2) + 4 * hh; const bool z = (grow & 255) == 255;
                KCC[(size_t)grow * 64 + r32] = (bf16_t)f2bf(z ? 0.f : c0[r]); KCC[(size_t)grow * 64 + 32 + r32] = (bf16_t)f2bf(z ? 0.f : c1[r]); }
        }
    }
    SEAM(10);
    if (IN(11)) {
        const NsaT T{QB, X1B, KVB + 2 * KVS, KVB + 3 * KVS, KVB + 4 * KVS, KVB + 5 * KVS, KCC, KCC + (size_t)8192 * 64, GATES};
        for (int u = wg; u < 2048; u += G) { const int bk = u & 31, rr = u >> 5, rnd = rr >> 3, q = rr & 7;
            const int tile = 63 - (8 * rnd + ((rnd & 1) ? 7 - q : q)); nsa_unit(lds, bk >> 2, bk & 3, tile, T); }
    }
    SEAM(11);
    if (IN(12)) {
        pg8::Gemm g{X1B, WB_OUT, 1024, 1024}; pg8::StaticOrder S; S.init(128, 4, G, wg, 0);
        pg8::EpiResid E{Y16, XB};
        pg8::gemm_phase(lds, g, S, E, pg8::BOffPlain{1024});
    }
    SEAM(12);
    if (IN(13)) {
        f32x4 rw[16][2];
#pragma unroll
        for (int j = 0; j < 4; ++j)
#pragma unroll
            for (int k = 0; k < 4; ++k) { const float* rp = args.in[I_ROUTER] + (size_t)(4 * lane + 256 * j + k) * 8; rw[4 * j + k][0] = *(const f32x4*)rp; rw[4 * j + k][1] = *(const f32x4*)(rp + 4); }
        LAS int* cntl = (LAS int*)lds;
        for (int u = wg; u < TTOK / 128; u += G) {
            int c[8];
#pragma unroll
            for (int e = 0; e < 8; ++e) c[e] = 0;
            int me1 = 0, me2 = 0, ms1 = 0, ms2 = 0; float mw1 = 0.f, mw2 = 0.f;
            for (int i = 0; i < 16; ++i) {
                const int m = u * 128 + wave * 16 + i; f32x4 v[4]; load_row_bf16(v, Y16 + (size_t)m * DM, lane);
                ln_apply(v, args.in[I_LNG] + 2048, args.in[I_LNB] + 2048, lane); store_row_bf16(X3B + (size_t)m * DM, v, lane);
                float lg[8];
#pragma unroll
                for (int e = 0; e < 8; ++e) lg[e] = 0.f;
#pragma unroll
                for (int j = 0; j < 4; ++j)
#pragma unroll
                    for (int k = 0; k < 4; ++k) { const float x = v[j][k];
#pragma unroll
                        for (int e = 0; e < 4; ++e) { lg[e] += x * rw[4 * j + k][0][e]; lg[4 + e] += x * rw[4 * j + k][1][e]; } }
#pragma unroll
                for (int e = 0; e < 8; ++e) lg[e] = wave_sum(lg[e]);
                int e1 = 0; float v1 = lg[0];
#pragma unroll
                for (int e = 1; e < 8; ++e) if (lg[e] > v1) { v1 = lg[e]; e1 = e; }
                int e2 = -1; float v2 = 0.f;
#pragma unroll
                for (int e = 0; e < 8; ++e) if (e != e1 && (e2 < 0 || lg[e] > v2)) { v2 = lg[e]; e2 = e; }
                const float ex = __expf(v2 - v1), w1 = 1.f / (1.f + ex), w2 = ex * w1;
                int s1 = 0, s2 = 0;
#pragma unroll
                for (int e = 0; e < 8; ++e) { if (e == e1) s1 = c[e]; if (e == e2) s2 = c[e]; c[e] += (e == e1 || e == e2) ? 1 : 0; }
                if (lane == i) { me1 = e1; me2 = e2; ms1 = s1; ms2 = s2; mw1 = w1; mw2 = w2; }
            }
            __syncthreads();
            if (lane < 8) { int cv = 0;
#pragma unroll
                for (int e = 0; e < 8; ++e) if (lane == e) cv = c[e];
                cntl[wave * 8 + lane] = cv; }
            __syncthreads();
            if (tid < 8) { int tot = 0;
#pragma unroll
                for (int w = 0; w < 8; ++w) tot += cntl[w * 8 + tid];
                int base = (int)__hip_atomic_fetch_add(ctl + CW_CNT + 64 * tid, (unsigned)tot, __ATOMIC_RELAXED, __HIP_MEMORY_SCOPE_AGENT);
#pragma unroll
                for (int w = 0; w < 8; ++w) { cntl[64 + w * 8 + tid] = base; base += cntl[w * 8 + tid]; } }
            __syncthreads();
            if (lane < 16) { int* rp = ROUTE + (size_t)(u * 128 + wave * 16 + lane) * 8;
                rp[0] = me1; rp[1] = me2; rp[2] = cntl[64 + wave * 8 + me1] + ms1; rp[3] = cntl[64 + wave * 8 + me2] + ms2; ((float*)rp)[4] = mw1; ((float*)rp)[5] = mw2; }
        }
    }
    SEAM(13);
    if (IN(14)) {
        int toff[9]; moe_offsets(ctl, toff);
        for (int m = gw; m < TTOK; m += NGW) {
            const int* rp = ROUTE + (size_t)m * 8; const int e1 = __builtin_amdgcn_readfirstlane(rp[0]), e2 = __builtin_amdgcn_readfirstlane(rp[1]), s1 = __builtin_amdgcn_readfirstlane(rp[2]), s2 = __builtin_amdgcn_readfirstlane(rp[3]);
            int t1 = 0, t2 = 0;
#pragma unroll
            for (int e = 0; e < 8; ++e) { if (e == e1) t1 = toff[e]; if (e == e2) t2 = toff[e]; }
            const u32x4 a = *(const u32x4*)(X3B + (size_t)m * DM + lane * 8), b = *(const u32x4*)(X3B + (size_t)m * DM + 512 + lane * 8);
            bf16_t* d1 = XG + ((size_t)t1 * 256 + s1) * DM; bf16_t* d2 = XG + ((size_t)t2 * 256 + s2) * DM;
            *(u32x4*)(d1 + lane * 8) = a; *(u32x4*)(d1 + 512 + lane * 8) = b; *(u32x4*)(d2 + lane * 8) = a; *(u32x4*)(d2 + 512 + lane * 8) = b;
        }
    }
    SEAM(14);
    for (int c = 0; c < 5; ++c) {
        if (IN(15 + 2 * c)) {
            int toff[9]; moe_offsets(ctl, toff); const int nt = toff[8] - 64 * c; const int ntc = nt < 0 ? 0 : (nt > 64 ? 64 : nt);
            pg8::Gemm g{XG, MOE_GU, 1024, 1024}; pg8::StaticOrder S; S.init(ntc, 28, G, wg, 64 * c);
            pg8::EpiSwiglu E{HMOE, DFF, 64 * c * 256};
            pg8::gemm_phase(lds, g, S, E, BOffMoe{toff[1], toff[2], toff[3], toff[4], toff[5], toff[6], toff[7], (size_t)2 * DFF * 1024 * 2, (size_t)256 * 1024 * 2});
        }
        SEAM(15 + 2 * c);
        if (IN(16 + 2 * c)) {
            int toff[9]; moe_offsets(ctl, toff); const int nt = toff[8] - 64 * c; const int ntc = nt < 0 ? 0 : (nt > 64 ? 64 : nt);
            pg8::Gemm g{HMOE - (size_t)64 * c * 256 * DFF, MOE_D, DFF, DFF}; pg8::StaticOrder S; S.init(ntc, 4, G, wg, 64 * c);
            pg8::EpiBf16<0> E{XG, 1024, nullptr};
            pg8::gemm_phase(lds, g, S, E, BOffMoe{toff[1], toff[2], toff[3], toff[4], toff[5], toff[6], toff[7], (size_t)1024 * DFF * 2, (size_t)256 * DFF * 2});
        }
        SEAM(16 + 2 * c);
    }
    if (IN(25)) {
        int toff[9]; moe_offsets(ctl, toff);
        for (int m = gw; m < TTOK; m += NGW) {
            const int* rp = ROUTE + (size_t)m * 8; const int e1 = __builtin_amdgcn_readfirstlane(rp[0]), e2 = __builtin_amdgcn_readfirstlane(rp[1]), s1 = __builtin_amdgcn_readfirstlane(rp[2]), s2 = __builtin_amdgcn_readfirstlane(rp[3]);
            const float w1 = __uint_as_float(__builtin_amdgcn_readfirstlane(rp[4])), w2 = __uint_as_float(__builtin_amdgcn_readfirstlane(rp[5]));
            int t1 = 0, t2 = 0;
#pragma unroll
            for (int e = 0; e < 8; ++e) { if (e == e1) t1 = toff[e]; if (e == e2) t2 = toff[e]; }
            f32x4 x[4], y1[4], y2[4];
            load_row_bf16(x, X3B + (size_t)m * DM, lane); load_row_bf16(y1, XG + ((size_t)t1 * 256 + s1) * DM, lane); load_row_bf16(y2, XG + ((size_t)t2 * 256 + s2) * DM, lane);
#pragma unroll
            for (int j = 0; j < 4; ++j) x[j] = x[j] * DN_ALPHA + (y1[j] * w1 + y2[j] * w2);
            ln_apply(x, args.in[I_LNG] + 3072, args.in[I_LNB] + 3072, lane);
#pragma unroll
            for (int j = 0; j < 4; ++j) *(f32x4*)(args.out + (size_t)m * DM + 4 * lane + 256 * j) = x[j];
        }
    }
#undef IN
#undef SEAM
}

#ifndef MK_PER_PHASE
#define MK_PER_PHASE 0
#endif
extern "C" void kernel_launch(void* const* d_in, const int* in_sizes, int n_in, void* d_out, int out_size, void* d_ws, size_t ws_size, hipStream_t stream) {
    static int grid = 0;
    if (grid == 0) {
        if (n_in != 21 || in_sizes[0] != TTOK * DM || out_size != TTOK * DM || ws_size < WS_END) { fprintf(stderr, "kernel_launch: unexpected shapes (n_in %d, ws %zu < %zu?)\n", n_in, ws_size, (size_t)WS_END); grid = -1; return; }
        int dev = 0, cus = 0;
        if (hipGetDevice(&dev) != hipSuccess || hipDeviceGetAttribute(&cus, hipDeviceAttributeMultiprocessorCount, dev) != hipSuccess) { grid = -1; return; }
        if (hipFuncSetAttribute((const void*)fwd, hipFuncAttributeMaxDynamicSharedMemorySize, LDS_BYTES) != hipSuccess) { fprintf(stderr, "kernel_launch: hipFuncSetAttribute failed\n"); grid = -1; return; }
        int per_cu = 0;
        if (hipOccupancyMaxActiveBlocksPerMultiprocessor(&per_cu, (const void*)fwd, 512, LDS_BYTES) != hipSuccess || per_cu < 1) { fprintf(stderr, "kernel_launch: occupancy query says %d\n", per_cu); }
        (void)hipGetLastError();
        grid = cus;
    }
    if (grid < 0) return;
    (void)hipMemsetAsync((char*)d_ws + WS_CTL, 0, CTL_ZERO_BYTES, stream);
    Args a{};
    for (int i = 0; i < 21; ++i) a.in[i] = (const float*)d_in[i];
    a.out = (float*)d_out; a.ws = (unsigned char*)d_ws;
#if MK_PER_PHASE
    for (int p = 0; p < NPH; ++p) { a.ph_lo = p; a.ph_hi = p + 1; hipLaunchKernelGGL(fwd, dim3(grid), dim3(512), LDS_BYTES, stream, a); }
#elif defined(DUP_LO)
    a.ph_lo = 0; a.ph_hi = DUP_HI; a.li = 0; hipLaunchKernelGGL(fwd, dim3(grid), dim3(512), LDS_BYTES, stream, a);
    a.ph_lo = DUP_LO; a.ph_hi = NPH; a.li = 1; hipLaunchKernelGGL(fwd, dim3(grid), dim3(512), LDS_BYTES, stream, a);
#else
    a.ph_lo = 0; a.ph_hi = NPH; hipLaunchKernelGGL(fwd, dim3(grid), dim3(512), LDS_BYTES, stream, a);
#endif
}
```

```cpp
#include <hip/hip_runtime.h>
#include <cstdio>
#include <cstdint>
#include <cmath>

#define LAS __attribute__((address_space(3)))
#define GAS __attribute__((address_space(1)))

typedef unsigned short bf16_t;
typedef short bf16x8 __attribute__((ext_vector_type(8)));
typedef short s16x4 __attribute__((ext_vector_type(4)));
typedef float f32x4 __attribute__((ext_vector_type(4)));
typedef float f32x2 __attribute__((ext_vector_type(2)));
typedef float f32x16 __attribute__((ext_vector_type(16)));
typedef unsigned u32x4 __attribute__((ext_vector_type(4)));
typedef unsigned u32x2 __attribute__((ext_vector_type(2)));

constexpr int NB = 8, SEQ = 4096, TTOK = NB * SEQ, DM = 1024, DFF = 3584, NEXP = 8, HD = 64, NKV = 4;
constexpr float DN_ALPHA = 1.4142135623730951f;
constexpr float LN_EPS = 1e-5f;
constexpr float QSCALE = 0.125f * 1.4426950408889634f;
constexpr float LOG2E = 1.4426950408889634f;
constexpr int NSA_IN = 2608, NSA_IN_PAD = 2816;

__device__ __forceinline__ unsigned cvt_pk_bf16(float lo, float hi) { unsigned r; asm volatile("v_cvt_pk_bf16_f32 %0, %1, %2" : "=v"(r) : "v"(lo), "v"(hi)); return r; }
__device__ __forceinline__ float bf_lo(unsigned w) { return __uint_as_float(w << 16); }
__device__ __forceinline__ float bf_hi(unsigned w) { return __uint_as_float(w & 0xffff0000u); }

namespace pg8 {
constexpr int BM = 256, BK = 64, HALF = 128, HTB = HALF * BK * 2, STAGE_BYTES = 8 * HTB, NXCD = 8, WGM = 8;
__host__ __device__ __forceinline__ int lds_byte(int r, int c) { const int st = (r >> 4) * 2 + (c >> 5), rr = r & 15, cc = c & 31, ob = rr * 64 + cc * 2; return st * 1024 + (ob ^ (((ob >> 9) & 1) << 5)); }
__host__ __device__ __forceinline__ void stage_rc(int b, int& R, int& C) { const int st = b / 1024, sb = b % 1024, swz = sb ^ (((sb >> 9) & 1) << 5); R = (st >> 1) * 16 + swz / 64; C = (st & 1) * 32 + (swz % 64) / 2; }
__host__ __device__ __forceinline__ int perm32(int rho) { const int n = rho >> 4, i = rho & 15; return 8 * (i >> 2) + 4 * n + (i & 3); }

struct Unit { int pm, pn; };
struct Gemm { int lda; int K; };

struct StaticOrder {
    int nM, nN, nwg, G, c, pm0, gap_at, gap;
    __device__ void init(int nM_, int nN_, int G_, int c_, int pm0_, int gap_at_ = 1 << 30, int gap_ = 0) { nM = nM_; nN = nN_; nwg = nM * nN; G = G_; c = c_; pm0 = pm0_; gap_at = gap_at_; gap = gap_; }
    __device__ bool next(int i, Unit& u) const {
        const long L = (long)i * G + c; if (L >= nwg) return false;
        int wgid = (int)L; { const int q = nwg / NXCD, r = nwg % NXCD, xcd = wgid % NXCD, off = wgid / NXCD; wgid = (xcd < r ? xcd * (q + 1) : r * (q + 1) + (xcd - r) * q) + off; }
        const int nig = WGM * nN, gid = wgid / nig, fm = gid * WGM, gsz = (nM - fm) < WGM ? (nM - fm) : WGM;
        u.pm = pm0 + fm + ((wgid % nig) % gsz); u.pn = (wgid % nig) / gsz; if (u.pm >= gap_at) u.pm += gap; return true;
    }
};
struct SkewOrder : StaticOrder {
    int nskip, skip;
    __device__ bool next(int i, Unit& u) const {
        const int round = (c < nskip) ? i + skip : i; long L;
        if (round < skip) L = (long)round * (G - nskip) + (c - nskip); else L = (long)skip * (G - nskip) + (long)(round - skip) * G + c;
        if (L >= nwg) return false;
        int wgid = (int)L; { const int q = nwg / NXCD, r = nwg % NXCD, xcd = wgid % NXCD, off = wgid / NXCD; wgid = (xcd < r ? xcd * (q + 1) : r * (q + 1) + (xcd - r) * q) + off; }
        const int nig = WGM * nN, gid = wgid / nig, fm = gid * WGM, gsz = (nM - fm) < WGM ? (nM - fm) : WGM;
        u.pm = pm0 + fm + ((wgid % nig) % gsz); u.pn = (wgid % nig) / gsz; return true;
    }
};

template <class Epi, class Sched, class Bases>
__device__ __forceinline__ void gemm_phase(LAS unsigned char* lds, const Gemm g, const Sched& S, const Epi& E, const Bases& BS) {
    const int tid = threadIdx.x, wid = __builtin_amdgcn_readfirstlane(tid >> 6), lane = tid & 63, wr = wid >> 2, wc = wid & 3, fr = lane & 15, fq = lane >> 4;
    const int K = g.K, nt = K / BK;
    unsigned voffA[2], voffB[2];
#pragma unroll
    for (int i = 0; i < 2; ++i) { int R, C; stage_rc(tid * 16 + i * 8192, R, C); const int Rb = Epi::PERM ? ((R & ~31) + perm32(R & 31)) : R;
        voffA[i] = (unsigned)(R * g.lda + C) * 2u; voffB[i] = (unsigned)(Rb * K + C) * 2u; }
    const size_t kstep = (size_t)(BK * 2);
    const size_t hstepA = (size_t)HALF * g.lda * 2, hstepB = (size_t)HALF * K * 2;
    const unsigned ldsw = (unsigned)wid * 1024u;
    const int aoff = lds_byte(wr * 64 + fr, fq * 8), boffl = lds_byte(wc * 32 + fr, fq * 8);
#define PG8_SA(b, h) (((b) * 2 + (h)) * HTB)
#define PG8_SB(b, h) ((4 + (b) * 2 + (h)) * HTB)
#define PG8_STAGE(bufoff, gbase, voff) do { _Pragma("unroll") for (int _i = 0; _i < 2; ++_i) \
        __builtin_amdgcn_global_load_lds((const unsigned*)((const char*)(gbase) + (voff)[_i]), (LAS unsigned*)(lds + (bufoff) + ldsw + _i * 8192), 16, 0, 0); } while (0)
#define PG8_LDA(dst, b, h) do { _Pragma("unroll") for (int m = 0; m < 4; ++m) _Pragma("unroll") for (int k = 0; k < 2; ++k) dst[m][k] = *(const LAS bf16x8*)(lds + PG8_SA(b, h) + aoff + m * 2048 + k * 1024); } while (0)
#define PG8_LDB(dst, b, h) do { _Pragma("unroll") for (int n = 0; n < 2; ++n) _Pragma("unroll") for (int k = 0; k < 2; ++k) dst[n][k] = *(const LAS bf16x8*)(lds + PG8_SB(b, h) + boffl + n * 2048 + k * 1024); } while (0)
#define PG8_MMA(ai, bj, At, Bt) do { __builtin_amdgcn_s_setprio(1); _Pragma("unroll") for (int m = 0; m < 4; ++m) _Pragma("unroll") for (int n = 0; n < 2; ++n) _Pragma("unroll") for (int k = 0; k < 2; ++k) \
        acc[ai][bj][m][n] = __builtin_amdgcn_mfma_f32_16x16x32_bf16(Bt[n][k], At[m][k], acc[ai][bj][m][n], 0, 0, 0); __builtin_amdgcn_s_setprio(0); } while (0)
#define PG8_WAIT_V(n) asm volatile("s_waitcnt vmcnt(" #n ")" ::: "memory")
#define PG8_WAIT_L(n) asm volatile("s_waitcnt lgkmcnt(" #n ")" ::: "memory")
#define PG8_BAR __builtin_amdgcn_s_barrier()
#define PG8_SCHED __builtin_amdgcn_sched_barrier(0)
    Unit cur, nxt; int ui = 0;
    if (!S.next(0, cur)) return;
    f32x4 acc[2][2][4][2];
#pragma unroll
    for (int a = 0; a < 2; ++a)
#pragma unroll
        for (int b = 0; b < 2; ++b)
#pragma unroll
            for (int m = 0; m < 4; ++m)
#pragma unroll
                for (int n = 0; n < 2; ++n) acc[a][b][m][n] = (f32x4){0.f, 0.f, 0.f, 0.f};
    bf16x8 At[4][2], B0[2][2], B1[2][2];
    const char* cA = BS.a(cur); const char* cB = BS.b(cur);
    PG8_STAGE(PG8_SB(0, 0), cB, voffB); PG8_STAGE(PG8_SB(0, 1), cB + hstepB, voffB); PG8_STAGE(PG8_SA(0, 0), cA, voffA); PG8_STAGE(PG8_SA(0, 1), cA + hstepA, voffA);
    if (wr == 1) PG8_BAR;
    PG8_WAIT_V(2); PG8_BAR;
    PG8_STAGE(PG8_SB(1, 0), cB + kstep, voffB); PG8_STAGE(PG8_SA(1, 0), cA + kstep, voffA); PG8_STAGE(PG8_SB(1, 1), cB + hstepB + kstep, voffB);
    PG8_WAIT_V(6); PG8_BAR;
    for (;;) {
        const bool has_next = S.next(ui + 1, nxt);
        const char* nA = has_next ? BS.a(nxt) : cA; const char* nB = has_next ? BS.b(nxt) : cB;
        for (int t = 0; t < nt; t += 2) {
            const bool last = (t == nt - 2);
            const char* a1 = cA + (size_t)(t + 1) * kstep;
            const char* a2 = last ? nA : cA + (size_t)(t + 2) * kstep; const char* b2 = last ? nB : cB + (size_t)(t + 2) * kstep;
            const char* a3 = a2 + kstep; const char* b3 = b2 + kstep;
            PG8_LDB(B0, 0, 0); PG8_LDB(B1, 0, 1); PG8_SCHED; PG8_LDA(At, 0, 0); PG8_STAGE(PG8_SA(1, 1), a1 + hstepA, voffA);
            PG8_WAIT_V(8); PG8_WAIT_L(0); PG8_BAR; PG8_MMA(0, 0, At, B0); PG8_MMA(0, 1, At, B1); PG8_BAR; PG8_SCHED;
            PG8_LDA(At, 0, 1); PG8_STAGE(PG8_SB(0, 0), b2, voffB); PG8_STAGE(PG8_SB(0, 1), b2 + hstepB, voffB); PG8_STAGE(PG8_SA(0, 0), a2, voffA);
            PG8_WAIT_V(8); PG8_WAIT_L(0); PG8_BAR; PG8_MMA(1, 0, At, B0); PG8_MMA(1, 1, At, B1); PG8_BAR; PG8_SCHED;
            PG8_LDB(B0, 1, 0); PG8_LDB(B1, 1, 1); PG8_SCHED; PG8_LDA(At, 1, 0); PG8_STAGE(PG8_SA(0, 1), a2 + hstepA, voffA);
            PG8_WAIT_V(8); PG8_WAIT_L(0); PG8_BAR; PG8_MMA(0, 0, At, B0); PG8_MMA(0, 1, At, B1); PG8_BAR; PG8_SCHED;
            PG8_LDA(At, 1, 1); PG8_STAGE(PG8_SB(1, 0), b3, voffB); PG8_STAGE(PG8_SB(1, 1), b3 + hstepB, voffB); PG8_STAGE(PG8_SA(1, 0), a3, voffA);
            PG8_WAIT_V(8); PG8_WAIT_L(0); PG8_BAR; PG8_MMA(1, 0, At, B0); PG8_MMA(1, 1, At, B1); PG8_BAR; PG8_SCHED;
        }
        if (wr == 0) PG8_BAR;
        E(acc, cur, wr, wc, fr, fq);
        if (!has_next) break;
#pragma unroll
        for (int a = 0; a < 2; ++a)
#pragma unroll
            for (int b = 0; b < 2; ++b)
#pragma unroll
                for (int m = 0; m < 4; ++m)
#pragma unroll
                    for (int n = 0; n < 2; ++n) acc[a][b][m][n] = (f32x4){0.f, 0.f, 0.f, 0.f};
        cur = nxt; cA = nA; cB = nB; ++ui;
        if (wr == 1) PG8_BAR;
    }
    PG8_WAIT_V(0);
    PG8_BAR;
#undef PG8_SA
#undef PG8_SB
#undef PG8_STAGE
#undef PG8_LDA
#undef PG8_LDB
#undef PG8_MMA
#undef PG8_WAIT_V
#undef PG8_WAIT_L
#undef PG8_BAR
#undef PG8_SCHED
}
struct BasesPlain { const bf16_t* A; const bf16_t* Bt; int lda, K;
    __device__ __forceinline__ const char* a(const Unit& u) const { return (const char*)A + (size_t)u.pm * 256 * lda * 2; }
    __device__ __forceinline__ const char* b(const Unit& u) const { return (const char*)Bt + (size_t)u.pn * 256 * K * 2; } };

struct EpiProj {
    static constexpr bool PERM = true;
    bf16_t* Q; bf16_t* KV; size_t kvstride; float* gates; const float* rope; int ropemask; int gate_tile; int natmask;
    __device__ __forceinline__ void operator()(const f32x4 (&acc)[2][2][4][2], const Unit& u, int wr, int wc, int fr, int fq) const {
        const int pn = u.pn;
        const int row00 = u.pm * BM + wr * 64 + fr;
        const int cw = wc * 32 + 8 * fq, j4 = (cw & 63) >> 1;
        if (pn == gate_tile) {
            if (cw < 48) {
#pragma unroll
                for (int ai = 0; ai < 2; ++ai)
#pragma unroll
                    for (int m = 0; m < 4; ++m) { const int row = row00 + ai * HALF + m * 16; float* gp = gates + (size_t)row * 48 + cw; const f32x4 v0 = acc[ai][0][m][0], v1 = acc[ai][0][m][1]; f32x4 s0, s1;
#pragma unroll
                        for (int k = 0; k < 4; ++k) { s0[k] = __builtin_amdgcn_rcpf(1.f + __builtin_amdgcn_exp2f(-v0[k] * LOG2E)); s1[k] = __builtin_amdgcn_rcpf(1.f + __builtin_amdgcn_exp2f(-v1[k] * LOG2E)); }
                        *(f32x4*)gp = s0; *(f32x4*)(gp + 4) = s1; }
            }
            return;
        }
        const bool isq = pn < 4; const bool rp = isq || ((ropemask >> (pn - 4)) & 1); const bool nat = !isq && ((natmask >> (pn - 4)) & 1);
        bf16_t* const base = isq ? Q + pn * 256 : KV + (size_t)(pn - 4) * kvstride;
        if (rp) {
            f32x4 cs[2][4], sn[2][4];
#pragma unroll
            for (int ai = 0; ai < 2; ++ai)
#pragma unroll
                for (int m = 0; m < 4; ++m) { const int t = (row00 + ai * HALF + m * 16) & (SEQ - 1); cs[ai][m] = *(const f32x4*)(rope + (size_t)t * 64 + j4); sn[ai][m] = *(const f32x4*)(rope + (size_t)t * 64 + 32 + j4); }
#pragma unroll
            for (int ai = 0; ai < 2; ++ai)
#pragma unroll
                for (int m = 0; m < 4; ++m) { const int row = row00 + ai * HALF + m * 16, t = row & (SEQ - 1), b = row >> 12;
#pragma unroll
                    for (int bj = 0; bj < 2; ++bj) { const int hl = (bj * HALF + cw) >> 6;
                        bf16_t* dst = isq ? base + (size_t)row * DM + hl * 64 : base + ((size_t)(b * NKV + hl) * SEQ + t) * HD;
                        const f32x4 v0 = acc[ai][bj][m][0], v1 = acc[ai][bj][m][1];
                        f32x4 o1 = v0 * cs[ai][m] - v1 * sn[ai][m], o2 = v1 * cs[ai][m] + v0 * sn[ai][m];
                        if (isq) { o1 = o1 * QSCALE; o2 = o2 * QSCALE; }
                        u32x4 w; w.x = cvt_pk_bf16(o1[0], o1[1]); w.y = cvt_pk_bf16(o1[2], o1[3]); w.z = cvt_pk_bf16(o2[0], o2[1]); w.w = cvt_pk_bf16(o2[2], o2[3]);
                        if (nat) { *(u32x2*)(dst + j4) = (u32x2){w.x, w.y}; *(u32x2*)(dst + 32 + j4) = (u32x2){w.z, w.w}; }
                        else *(u32x4*)(dst + (cw & 63)) = w; } }
        } else {
#pragma unroll
            for (int ai = 0; ai < 2; ++ai)
#pragma unroll
                for (int m = 0; m < 4; ++m) { const int row = row00 + ai * HALF + m * 16, t = row & (SEQ - 1), b = row >> 12;
#pragma unroll
                    for (int bj = 0; bj < 2; ++bj) { const int hl = (bj * HALF + cw) >> 6; bf16_t* dst = base + ((size_t)(b * NKV + hl) * SEQ + t) * HD + (cw & 63);
                        const f32x4 v0 = acc[ai][bj][m][0], v1 = acc[ai][bj][m][1];
                        u32x4 w; w.x = cvt_pk_bf16(v0[0], v0[1]); w.y = cvt_pk_bf16(v0[2], v0[3]); w.z = cvt_pk_bf16(v1[0], v1[1]); w.w = cvt_pk_bf16(v1[2], v1[3]);
                        *(u32x4*)dst = w; } }
        }
    }
};
struct EpiResid {
    static constexpr bool PERM = true;
    bf16_t* Y; const bf16_t* R;
    __device__ __forceinline__ void operator()(const f32x4 (&acc)[2][2][4][2], const Unit& u, int wr, int wc, int fr, int fq) const {
        const int row0 = u.pm * BM + wr * 64 + fr, col0 = u.pn * BM + wc * 32 + 8 * fq;
        u32x4 rw[2][4][2];
#pragma unroll
        for (int ai = 0; ai < 2; ++ai)
#pragma unroll
            for (int m = 0; m < 4; ++m) { const size_t off = (size_t)(row0 + ai * HALF + m * 16) * DM + col0;
#pragma unroll
                for (int bj = 0; bj < 2; ++bj) rw[ai][m][bj] = *(const u32x4*)(R + off + bj * HALF); }
#pragma unroll
        for (int ai = 0; ai < 2; ++ai)
#pragma unroll
            for (int m = 0; m < 4; ++m) { const size_t off = (size_t)(row0 + ai * HALF + m * 16) * DM + col0;
#pragma unroll
                for (int bj = 0; bj < 2; ++bj) { const u32x4 r4 = rw[ai][m][bj]; const f32x4 a = acc[ai][bj][m][0], b = acc[ai][bj][m][1]; u32x4 w;
                    w.x = cvt_pk_bf16(a[0] + DN_ALPHA * bf_lo(r4.x), a[1] + DN_ALPHA * bf_hi(r4.x)); w.y = cvt_pk_bf16(a[2] + DN_ALPHA * bf_lo(r4.y), a[3] + DN_ALPHA * bf_hi(r4.y));
                    w.z = cvt_pk_bf16(b[0] + DN_ALPHA * bf_lo(r4.z), b[1] + DN_ALPHA * bf_hi(r4.z)); w.w = cvt_pk_bf16(b[2] + DN_ALPHA * bf_lo(r4.w), b[3] + DN_ALPHA * bf_hi(r4.w));
                    *(u32x4*)(Y + off + bj * HALF) = w; } }
    }
};
template <class HBase> struct EpiSwiglu {
    static constexpr bool PERM = true;
    HBase hb; int ldh;
    __device__ __forceinline__ void operator()(const f32x4 (&acc)[2][2][4][2], const Unit& u, int wr, int wc, int fr, int fq) const {
        bf16_t* const H = hb(u.pm);
        const int row0 = wr * 64 + fr, col0 = u.pn * HALF + wc * 32 + 8 * fq;
#pragma unroll
        for (int ai = 0; ai < 2; ++ai)
#pragma unroll
            for (int m = 0; m < 4; ++m) { bf16_t* rowp = H + (size_t)(row0 + ai * HALF + m * 16) * ldh + col0; float o[8];
#pragma unroll
                for (int n = 0; n < 2; ++n)
#pragma unroll
                    for (int k = 0; k < 4; ++k) { const float gv = acc[ai][0][m][n][k], uv = acc[ai][1][m][n][k];
                        o[4 * n + k] = gv * __builtin_amdgcn_rcpf(1.f + __builtin_amdgcn_exp2f(-gv * LOG2E)) * uv; }
                u32x4 w; w.x = cvt_pk_bf16(o[0], o[1]); w.y = cvt_pk_bf16(o[2], o[3]); w.z = cvt_pk_bf16(o[4], o[5]); w.w = cvt_pk_bf16(o[6], o[7]);
                *(u32x4*)rowp = w; }
    }
};
template <int ACT> struct EpiBf16 {
    static constexpr bool PERM = true;
    bf16_t* O; int ldc; const float* bias;
    __device__ __forceinline__ void operator()(const f32x4 (&acc)[2][2][4][2], const Unit& u, int wr, int wc, int fr, int fq) const {
        const int row0 = u.pm * BM + wr * 64 + fr, col0 = u.pn * BM + wc * 32 + 8 * fq;
#pragma unroll
        for (int ai = 0; ai < 2; ++ai)
#pragma unroll
            for (int m = 0; m < 4; ++m) { bf16_t* rowp = O + (size_t)(row0 + ai * HALF + m * 16) * ldc + col0;
#pragma unroll
                for (int bj = 0; bj < 2; ++bj) { f32x4 v0 = acc[ai][bj][m][0], v1 = acc[ai][bj][m][1];
                    if (ACT == 1) { const f32x4 b0 = *(const f32x4*)(bias + col0 + bj * HALF), b1 = *(const f32x4*)(bias + col0 + bj * HALF + 4); v0 = v0 + b0; v1 = v1 + b1;
#pragma unroll
                        for (int k = 0; k < 4; ++k) {
                            { const float x = v0[k], z = 1.5957691216057308f * (x + 0.044715f * x * x * x); v0[k] = x * __builtin_amdgcn_rcpf(1.f + __builtin_amdgcn_exp2f(-z * LOG2E)); }
                            { const float x = v1[k], z = 1.5957691216057308f * (x + 0.044715f * x * x * x); v1[k] = x * __builtin_amdgcn_rcpf(1.f + __builtin_amdgcn_exp2f(-z * LOG2E)); } } }
                    u32x4 w; w.x = cvt_pk_bf16(v0[0], v0[1]); w.y = cvt_pk_bf16(v0[2], v0[3]); w.z = cvt_pk_bf16(v1[0], v1[1]); w.w = cvt_pk_bf16(v1[2], v1[3]);
                    *(u32x4*)(rowp + bj * HALF) = w; } }
    }
};
}

constexpr size_t MiB = 1u << 20;
constexpr size_t WS_CTL = 0, CTL_ZERO_BYTES = 64 * 1024;
constexpr size_t WS_ROPE = 1 * MiB;
constexpr size_t WS_ROUTE = 2 * MiB;
constexpr size_t WS_KCC = 3 * MiB, WS_VCC = 4 * MiB;
constexpr size_t WS_MISC = 5 * MiB;
constexpr size_t WS_GATES = 6 * MiB;
constexpr size_t WS_WA_IN = 16 * MiB, WS_WA_OUT = 19 * MiB, WS_WB_IN = 21 * MiB, WS_WB_OUT = 27 * MiB, WS_CW1K = 29 * MiB, WS_CW1V = 30 * MiB;
constexpr size_t WS_FFN_GU = 31 * MiB, WS_FFN_D = 45 * MiB, WS_MOE_GU = 52 * MiB, WS_MOE_D = 164 * MiB;
constexpr size_t WS_ACT = 220 * MiB;
constexpr size_t WS_XB = WS_ACT;
constexpr size_t WS_Q = WS_ACT + 64 * MiB;
constexpr size_t WS_KV = WS_ACT + 128 * MiB;
constexpr size_t KV_STRIDE_B = 16 * MiB;
constexpr size_t WS_HFF = WS_ACT;
constexpr size_t WS_X1B = WS_ACT + 224 * MiB;
constexpr size_t WS_CHID = WS_ACT + 224 * MiB;
constexpr size_t WS_X3B = WS_ACT;
constexpr size_t WS_XG = WS_ACT + 64 * MiB;
constexpr size_t WS_HMOE = WS_ACT + 196 * MiB;
constexpr size_t WS_END = WS_ACT + 308 * MiB;
static_assert(WS_MOE_D + 8 * 7 * MiB <= WS_ACT && WS_X1B + 64 * MiB <= WS_END && WS_HMOE + 112 * MiB <= WS_END && WS_XG + 132 * MiB <= WS_HMOE, "d_ws map");
constexpr int CW_CNT = 64;
constexpr int CW_BAR = 1024;

constexpr int RING_BYTES = 131072, LDSCTL_OFF = 135168, LDS_BYTES = 147456;

#define XB_TMO      128
#define XB_XCNT(j)  (256  + 64 * (j))
#define XB_XSUB(j)  (1280 + 64 * (j))
#define XB_XGEN(j)  (2304 + 64 * (j))
#define XB_TOP      3328
#define XB_TOPGEN   3392
#define XCD_BAR_WORDS 3456
#define XB_SPIN_CAP (1u << 18)
static_assert((CW_BAR + 2 * XCD_BAR_WORDS) * 4 <= (int)CTL_ZERO_BYTES, "CTL words inside the memset region");
__device__ __forceinline__ unsigned xb_ld(unsigned* p)              { return __hip_atomic_load(p, __ATOMIC_RELAXED, __HIP_MEMORY_SCOPE_AGENT); }
__device__ __forceinline__ unsigned xb_add(unsigned* p, unsigned v) { return __hip_atomic_fetch_add(p, v, __ATOMIC_RELAXED, __HIP_MEMORY_SCOPE_AGENT); }
__device__ __forceinline__ unsigned xb_xcc_id() { return (unsigned)__builtin_amdgcn_s_getreg((3 << 11) | 20) & 0xFu; }
#define XB_SPIN(cond, bar) do { unsigned _sp = 0; while (cond) { __builtin_amdgcn_s_sleep(1); \
    if ((++_sp & 255u) == 0u) { if (xb_ld(&(bar)[XB_TMO])) break; if (_sp > XB_SPIN_CAP) { atomicAdd(&(bar)[XB_TMO], 1u); break; } } } } while (0)
struct XcdBarrier { unsigned* bar; unsigned x; volatile LAS unsigned* st; };
__device__ __forceinline__ XcdBarrier xcd_barrier_post(unsigned* bar, volatile LAS unsigned* st) {
    XcdBarrier b; b.bar = bar; b.x = xb_xcc_id(); b.st = st;
    if (threadIdx.x == 0) (void)xb_add(&bar[XB_XCNT(b.x)], 1u);
    return b;
}
__device__ __forceinline__ void xcd_barrier_complete(unsigned* bar, unsigned x, unsigned& nloc, unsigned& nx) {
    const unsigned G = gridDim.x * gridDim.y * gridDim.z;
    unsigned sum, cnt, mine, sp = 0u;
    for (;;) {
        sum = 0u; cnt = 0u; mine = 0u;
#pragma unroll
        for (unsigned j = 0; j < 16; ++j) { const unsigned c = xb_ld(&bar[XB_XCNT(j)]); sum += c; cnt += (c > 0u) ? 1u : 0u; mine = (j == x) ? c : mine; }
        if (sum == G) break;
        __builtin_amdgcn_s_sleep(1);
        if ((++sp & 255u) == 0u) { if (xb_ld(&bar[XB_TMO])) break; if (sp > XB_SPIN_CAP) { atomicAdd(&bar[XB_TMO], 1u); break; } }
    }
    nloc = mine > 0u ? mine : 1u; nx = cnt > 0u ? cnt : 1u;
}
__device__ __forceinline__ void xcd_barrier(const XcdBarrier& b) {
    asm volatile("s_waitcnt vmcnt(0)" ::: "memory");
    __syncthreads();
    if (threadIdx.x == 0) {
        unsigned* bar = b.bar;
        __builtin_amdgcn_s_waitcnt(0);
        unsigned nloc = b.st[0], nx = b.st[1];
        if (nloc == 0u) { xcd_barrier_complete(bar, b.x, nloc, nx); b.st[0] = nloc; b.st[1] = nx; }
        const unsigned old = xb_add(&bar[XB_XSUB(b.x)], 1u);
        const unsigned gen = old / nloc;
        if (old + 1u == (gen + 1u) * nloc) {
            __builtin_amdgcn_fence(__ATOMIC_RELEASE, "agent");
            asm volatile("s_waitcnt vmcnt(0)" ::: "memory");
            const unsigned og = xb_add(&bar[XB_TOP], 1u);
            const unsigned tg = og / nx;
            if (og + 1u == (tg + 1u) * nx) xb_add(&bar[XB_TOPGEN], 1u);
            else XB_SPIN(xb_ld(&bar[XB_TOPGEN]) == tg, bar);
            __builtin_amdgcn_fence(__ATOMIC_ACQUIRE, "agent");
            xb_add(&bar[XB_XGEN(b.x)], 1u);
            asm volatile("s_waitcnt vmcnt(0)" ::: "memory");
        } else {
            XB_SPIN(xb_ld(&bar[XB_XGEN(b.x)]) == gen, bar);
            __builtin_amdgcn_fence(__ATOMIC_ACQUIRE, "agent");
            asm volatile("s_waitcnt vmcnt(0)" ::: "memory");
        }
    }
    __syncthreads();
}

__device__ __forceinline__ float wave_sum(float v) {
#pragma unroll
    for (int o = 1; o < 64; o <<= 1) v += __shfl_xor(v, o);
    return v;
}
__device__ __forceinline__ unsigned f2bf(float f) { unsigned u = __float_as_uint(f); return (u + 0x7fffu + ((u >> 16) & 1u)) >> 16; }
__device__ __forceinline__ unsigned pk2(float lo, float hi) { return f2bf(lo) | (f2bf(hi) << 16); }
#define LDS_WAIT() asm volatile("s_waitcnt lgkmcnt(0)" ::: "memory")

__device__ __forceinline__ int wmap(int mode, int n) {
    if (mode == 1) { const int h = n & ~63, d = n & 63; return h + (d < 32 ? 8 * (d >> 2) + (d & 3) : 8 * ((d - 32) >> 2) + 4 + (d & 3)); }
    if (mode == 2) return ((n >> 7) << 8) + (n & 127);
    if (mode == 3) return ((n >> 7) << 8) + 128 + (n & 127);
    return n;
}
__device__ __forceinline__ void transpose_item(const float* W, int K, int N, bf16_t* WT, int row_off, int mode, LAS float* scr, int item, int lane) {
    const int nblk = (N + 31) / 32, kb = item / nblk, nb = item % nblk, k0 = 64 * kb, n0 = 32 * nb;
    const int nn = n0 + (lane & 31); const bool nok = nn < N;
#pragma unroll 8
    for (int i = 0; i < 32; ++i) { const int kk = 2 * i + (lane >> 5); scr[kk * 33 + (lane & 31)] = nok ? W[(size_t)(k0 + kk) * N + nn] : 0.f; }
    LDS_WAIT(); asm volatile("" ::: "memory");
    const int c = lane & 7;
#pragma unroll
    for (int j = 0; j < 4; ++j) { const int n = (lane >> 3) + 8 * j; const LAS float* s = scr + (8 * c) * 33 + n;
        u32x4 o; o.x = pk2(s[0 * 33], s[1 * 33]); o.y = pk2(s[2 * 33], s[3 * 33]); o.z = pk2(s[4 * 33], s[5 * 33]); o.w = pk2(s[6 * 33], s[7 * 33]);
        if (n0 + n < N) *(u32x4*)(WT + (size_t)(row_off + wmap(mode, n0 + n)) * K + k0 + 8 * c) = o; }
    LDS_WAIT(); asm volatile("" ::: "memory");
}

namespace att {
constexpr float NEG_INF = -__builtin_huge_valf();
constexpr float SENT = -1e30f;
constexpr float THR = 6.f;
struct St { float mhat, l; f32x16 o0, o1; };
__device__ __forceinline__ void st_init(St& s, float m0, float l0) { s.mhat = m0; s.l = l0;
#pragma unroll
    for (int r = 0; r < 16; ++r) { s.o0[r] = 0.f; s.o1[r] = 0.f; } }
__device__ __forceinline__ float xhalf(float v) { auto rr = __builtin_amdgcn_permlane32_swap(__float_as_uint(v), __float_as_uint(v), false, false); return __uint_as_float((threadIdx.x & 32) ? rr[0] : rr[1]); }
__device__ __forceinline__ float xmax(float v) { auto rr = __builtin_amdgcn_permlane32_swap(__float_as_uint(v), __float_as_uint(v), false, false); return __builtin_amdgcn_fmed3f(__uint_as_float(rr[0]), __uint_as_float(rr[1]), -NEG_INF); }
__device__ __forceinline__ void glds16(const void* gsrc, unsigned lds_dst) { unsigned keep;
    asm volatile("s_mov_b32 %0, m0\n\ts_mov_b32 m0, %2\n\ts_nop 0\n\tglobal_load_lds_dwordx4 %1, off\n\ts_mov_b32 m0, %0" : "=&s"(keep) : "v"(gsrc), "s"(lds_dst) : "memory"); }
#define ATT_WAIT_BAR() asm volatile("s_waitcnt vmcnt(0) lgkmcnt(0)\n\ts_barrier" ::: "memory")
__device__ __forceinline__ void kv_dma(const bf16_t* Kg, const bf16_t* Vg, LAS unsigned char* Ks, LAS unsigned char* Vs, int wid, int lane) {
    glds16(Kg + lane * 64 + wid * 8, (unsigned)__builtin_amdgcn_readfirstlane((unsigned)(uintptr_t)(Ks + wid * 1024)));
    glds16(Vg + (16 * (wid & 3) + (lane >> 2)) * 64 + (wid >> 2) * 32 + (lane & 3) * 8, (unsigned)__builtin_amdgcn_readfirstlane((unsigned)(uintptr_t)(Vs + wid * 1024)));
}
__device__ __forceinline__ s16x4 vtr(const LAS unsigned char* p) { typedef short v4i16_t __attribute__((ext_vector_type(4)));
    return __builtin_bit_cast(s16x4, __builtin_amdgcn_ds_read_tr16_b64_v4i16((LAS v4i16_t*)p)); }
__device__ __forceinline__ void qkt(f32x16& p0, f32x16& p1, const LAS unsigned char* Ks, const bf16x8 (&qr)[4], const f32x16& c, int lane) {
    const LAS unsigned char* kp = Ks + (lane >> 5) * 1024 + (lane & 31) * 16;
    { const bf16x8 b0 = *(const LAS bf16x8*)(kp), b1 = *(const LAS bf16x8*)(kp + 512);
      p0 = __builtin_amdgcn_mfma_f32_32x32x16_bf16(b0, qr[0], c, 0, 0, 0); p1 = __builtin_amdgcn_mfma_f32_32x32x16_bf16(b1, qr[0], c, 0, 0, 0); }
#pragma unroll
    for (int d0 = 1; d0 < 4; ++d0) {
        const bf16x8 b0 = *(const LAS bf16x8*)(kp + d0 * 2048), b1 = *(const LAS bf16x8*)(kp + d0 * 2048 + 512);
        p0 = __builtin_amdgcn_mfma_f32_32x32x16_bf16(b0, qr[d0], p0, 0, 0, 0);
        p1 = __builtin_amdgcn_mfma_f32_32x32x16_bf16(b1, qr[d0], p1, 0, 0, 0);
    }
}
__device__ __forceinline__ void kmask(f32x16& p0, f32x16& p1, int lo_c, int hi_c, int lane) {
    const int base = 4 * (lane >> 5) - lo_c; const unsigned span = (unsigned)(hi_c - lo_c);
#pragma unroll
    for (int r = 0; r < 16; ++r) { const int kv = (r & 3) + 8 * (r >> 2);
        if ((unsigned)(kv + base) > span) p0[r] = NEG_INF;
        if ((unsigned)(kv + 32 + base) > span) p1[r] = NEG_INF; }
}
__device__ __forceinline__ void pv(f32x16& o0, f32x16& o1, const f32x16& p0, const f32x16& p1, const LAS unsigned char* Vs, int lane) {
    const LAS unsigned char* vp = Vs + ((lane >> 4) & 1) * 32 + (lane & 3) * 8 + (4 * (lane >> 5) + ((lane & 15) >> 2)) * 64;
    u32x4 pw[4];
#pragma unroll
    for (int i = 0; i < 4; ++i) { pw[0][i] = cvt_pk_bf16(p0[2 * i], p0[2 * i + 1]); pw[1][i] = cvt_pk_bf16(p0[8 + 2 * i], p0[9 + 2 * i]);
                                  pw[2][i] = cvt_pk_bf16(p1[2 * i], p1[2 * i + 1]); pw[3][i] = cvt_pk_bf16(p1[8 + 2 * i], p1[9 + 2 * i]); }
#pragma unroll
    for (int s = 0; s < 4; ++s) {
        const s16x4 l0 = vtr(vp + s * 1024), h0 = vtr(vp + s * 1024 + 512), l1 = vtr(vp + 4096 + s * 1024), h1 = vtr(vp + 4096 + s * 1024 + 512);
        const bf16x8 v0 = (bf16x8){l0[0], l0[1], l0[2], l0[3], h0[0], h0[1], h0[2], h0[3]}, v1 = (bf16x8){l1[0], l1[1], l1[2], l1[3], h1[0], h1[1], h1[2], h1[3]};
        const bf16x8 pa = __builtin_bit_cast(bf16x8, pw[s]);
        o0 = __builtin_amdgcn_mfma_f32_32x32x16_bf16(v0, pa, o0, 0, 0, 0);
        o1 = __builtin_amdgcn_mfma_f32_32x32x16_bf16(v1, pa, o1, 0, 0, 0);
    }
}
__device__ __forceinline__ float rowmax(const f32x16& p0, const f32x16& p1) {
    float a = __builtin_amdgcn_fmed3f(p0[0], p1[0], -NEG_INF), b = __builtin_amdgcn_fmed3f(p0[1], p1[1], -NEG_INF);
#pragma unroll
    for (int r = 2; r < 16; r += 2) { a = __builtin_amdgcn_fmed3f(a, p0[r], -NEG_INF); b = __builtin_amdgcn_fmed3f(b, p0[r + 1], -NEG_INF); a = __builtin_amdgcn_fmed3f(a, p1[r], -NEG_INF); b = __builtin_amdgcn_fmed3f(b, p1[r + 1], -NEG_INF); }
    return xmax(__builtin_amdgcn_fmed3f(a, b, -NEG_INF));
}
template <bool MASK, bool PV>
__device__ __forceinline__ void block(const LAS unsigned char* Ks, const LAS unsigned char* Vs, const bf16x8 (&qr)[4], St& st, int lo_c, int hi_c, bool on, int lane) {
    f32x16 p0, p1;
    { f32x16 c; const float cm = on ? ((st.mhat == SENT) ? 0.f : -st.mhat) : NEG_INF;
#pragma unroll
        for (int r = 0; r < 16; ++r) c[r] = cm;
        qkt(p0, p1, Ks, qr, c, lane); }
    if (MASK) kmask(p0, p1, lo_c, hi_c, lane);
    const float rm = rowmax(p0, p1);
    const bool fresh = st.mhat == SENT, need = fresh ? (rm > NEG_INF) : (rm > THR);
    if (__any(need)) {
        const float dl = need ? rm : 0.f, f = (need && !fresh) ? __builtin_amdgcn_exp2f(-dl) : 1.f;
        st.mhat = need ? (fresh ? dl : st.mhat + dl) : st.mhat;
#pragma unroll
        for (int r = 0; r < 16; ++r) { p0[r] -= dl; p1[r] -= dl; }
        st.l *= f;
        if (PV) {
#pragma unroll
            for (int r = 0; r < 16; ++r) { st.o0[r] *= f; st.o1[r] *= f; } }
    }
    float sa = 0.f, sb = 0.f;
#pragma unroll
    for (int r = 0; r < 16; ++r) { p0[r] = __builtin_amdgcn_exp2f(p0[r]); p1[r] = __builtin_amdgcn_exp2f(p1[r]); sa += p0[r]; sb += p1[r]; }
    st.l += sa + sb;
    if (PV) pv(st.o0, st.o1, p0, p1, Vs, lane);
}
template <bool PV>
__device__ __forceinline__ void block_any(const LAS unsigned char* Ks, const LAS unsigned char* Vs, const bf16x8 (&qr)[4], St& st, int lo_rel, int hi_rel, bool extra_on, int lane) {
    const bool on = extra_on && hi_rel >= 0 && lo_rel <= 63;
    if (!__any(on)) return;
    const int lo_c = lo_rel < 0 ? 0 : lo_rel, hi_c = hi_rel > 63 ? 63 : hi_rel;
    if (__any(on && (lo_c > 0 || hi_c < 63))) block<true, PV>(Ks, Vs, qr, st, lo_c, hi_c, on, lane);
    else block<false, PV>(Ks, Vs, qr, st, 0, 63, on, lane);
}
__device__ __forceinline__ void load_q(bf16x8 (&qr)[4], const bf16_t* Qrow  , int lane) {
#pragma unroll
    for (int d0 = 0; d0 < 4; ++d0) qr[d0] = *(const bf16x8*)(Qrow + d0 * 16 + (lane >> 5) * 8);
}
__device__ __forceinline__ void fold(f32x16& a0, f32x16& a1, const St& st, float w) {
    const float lt = st.l + xhalf(st.l), sc = lt > 0.f ? w / lt : 0.f;
#pragma unroll
    for (int r = 0; r < 16; ++r) { a0[r] += sc * st.o0[r]; a1[r] += sc * st.o1[r]; }
}
__device__ __forceinline__ void acc_save(LAS unsigned char* p, const f32x16& a0, const f32x16& a1, int lane) {
    LAS u32x4* q = (LAS u32x4*)(p + lane * 64);
#pragma unroll
    for (int i = 0; i < 2; ++i) { u32x4 w0, w1;
#pragma unroll
        for (int k = 0; k < 4; ++k) { w0[k] = cvt_pk_bf16(a0[8 * i + 2 * k], a0[8 * i + 2 * k + 1]); w1[k] = cvt_pk_bf16(a1[8 * i + 2 * k], a1[8 * i + 2 * k + 1]); }
        q[i] = w0; q[2 + i] = w1; }
}
__device__ __forceinline__ void acc_load(const LAS unsigned char* p, f32x16& a0, f32x16& a1, int lane) {
    const LAS u32x4* q = (const LAS u32x4*)(p + lane * 64);
#pragma unroll
    for (int i = 0; i < 2; ++i) { const u32x4 w0 = q[i], w1 = q[2 + i];
#pragma unroll
        for (int k = 0; k < 4; ++k) { a0[8 * i + 2 * k] = bf_lo(w0[k]); a0[8 * i + 2 * k + 1] = bf_hi(w0[k]); a1[8 * i + 2 * k] = bf_lo(w1[k]); a1[8 * i + 2 * k + 1] = bf_hi(w1[k]); } }
}
__device__ __forceinline__ void store_o(bf16_t* Orow, const f32x16& a0, const f32x16& a1, int lane) {
    const int hi = lane >> 5;
#pragma unroll
    for (int r = 0; r < 16; r += 2) { const int d = (r & 3) + 8 * (r >> 2) + 4 * hi;
        *(unsigned*)(Orow + d) = cvt_pk_bf16(a0[r], a0[r + 1]); *(unsigned*)(Orow + 32 + d) = cvt_pk_bf16(a1[r], a1[r + 1]); }
}
}

__device__ __forceinline__ void swa_unit(LAS unsigned char* lds, int b, int kvh, int tile, const bf16_t* Q, const bf16_t* Kh, const bf16_t* Vh, bf16_t* O, const float* sinks) {
    int tid = threadIdx.x; asm volatile("" : "+v"(tid));
    const int lane = tid & 63, wid = __builtin_amdgcn_readfirstlane(tid >> 6), g = wid & 3, s = wid >> 2, r32 = lane & 31;
    const bf16_t* Kb = Kh + (size_t)(b * NKV + kvh) * SEQ * HD; const bf16_t* Vb = Vh + (size_t)(b * NKV + kvh) * SEQ * HD;
#pragma unroll
    for (int i = 0; i < 3; ++i) { const int j = tile - 2 + i; if (j >= 0) att::kv_dma(Kb + (size_t)j * 64 * HD, Vb + (size_t)j * 64 * HD, lds + i * 8192, lds + 24576 + i * 8192, wid, lane); }
    const int t = tile * 64 + s * 32 + r32, head = kvh * 4 + g;
    const size_t qoff = ((size_t)b * SEQ + t) * DM + head * HD;
    bf16x8 qr[4]; att::load_q(qr, Q + qoff, lane);
    const float sink = sinks[head];
    ATT_WAIT_BAR();
    att::St st; att::st_init(st, sink * LOG2E, (lane < 32) ? 1.f : 0.f);
#pragma unroll
    for (int i = 0; i < 3; ++i) { const int j = tile - 2 + i;
        if (j >= 0) att::block_any<true>(lds + i * 8192, lds + 24576 + i * 8192, qr, st, t - 127 - 64 * j, t - 64 * j, true, lane); }
    f32x16 a0, a1;
#pragma unroll
    for (int r = 0; r < 16; ++r) { a0[r] = 0.f; a1[r] = 0.f; }
    att::fold(a0, a1, st, 1.f);
    att::store_o(O + qoff, a0, a1, lane);
    ATT_WAIT_BAR();
}

static_assert(65536 + 4 * 64 * 65 * 4 <= LDSCTL_OFF, "NSA importance table below the LDS control words");
constexpr int NSA_IMP = 65536, NSA_IMPF = 0, NSA_SELM = 16640, NSA_SELU = 17152, NSA_KS = 32768;
struct NsaT { const bf16_t* Q; bf16_t* O; const bf16_t *KS, *VS, *KW, *VW, *KCC, *VCC; const float* gates; };
__device__ __forceinline__ void nsa_unit(LAS unsigned char* lds, int b, int kvh, int tile, const NsaT& T) {
    int tid = threadIdx.x; asm volatile("" : "+v"(tid));
    const int lane = tid & 63, wid = __builtin_amdgcn_readfirstlane(tid >> 6), g = wid & 3, s = wid >> 2, r32 = lane & 31, hi = lane >> 5;
    const int t = tile * 64 + s * 32 + r32, head = kvh * 4 + g, cur = tile;
    const size_t qoff = ((size_t)b * SEQ + t) * DM + head * HD;
    const size_t bh = (size_t)(b * NKV + kvh);
    {
        const bf16_t* Kc = T.KCC + bh * 256 * HD; const bf16_t* Vc = T.VCC + bh * 256 * HD;
#pragma unroll
        for (int i = 0; i < 4; ++i) att::kv_dma(Kc + i * 64 * HD, Vc + i * 64 * HD, lds + i * 8192, lds + 32768 + i * 8192, wid, lane);
    }
    bf16x8 qr[4]; att::load_q(qr, T.Q + qoff, lane);
    const float* gp = T.gates + ((size_t)b * SEQ + t) * 48 + head * 3;
    const float g_c = gp[0], g_s = gp[1], g_w = gp[2];
    ATT_WAIT_BAR();
    f32x16 a0, a1;
#pragma unroll
    for (int r = 0; r < 16; ++r) { a0[r] = 0.f; a1[r] = 0.f; }
    const int iv = (t - 31) >> 4;
    {
        att::St st; att::st_init(st, att::SENT, 0.f);
#pragma unroll 1
        for (int blk = 0; blk < 4; ++blk) att::block_any<false>(lds + blk * 8192, lds + 32768 + blk * 8192, qr, st, 0, iv - 64 * blk, true, lane);
        const float lt = st.l + att::xhalf(st.l), inv_l = lt > 0.f ? 1.f / lt : 0.f, mfin = st.mhat;
        f32x16 c0, c1;
#pragma unroll
        for (int r = 0; r < 16; ++r) { c0[r] = 0.f; c1[r] = 0.f; }
        int r32o = r32; asm volatile("" : "+v"(r32o));
        LAS float* imp_row = (LAS float*)(lds + NSA_IMP) + (g * 64 + s * 32 + r32o) * 65;
        float prevx = 0.f;
#pragma unroll 1
        for (int blk = 0; blk < 4; ++blk) {
            const int hi_rel = iv - 64 * blk; const bool on = hi_rel >= 0;
            if (!__any(on)) {
#pragma unroll
                for (int k = 0; k < 8; ++k) imp_row[16 * blk + 2 * k + hi] = 0.f;
                prevx = 0.f; continue;
            }
            f32x16 p0, p1, cinit; const float cm = on ? -mfin : att::NEG_INF;
#pragma unroll
            for (int r = 0; r < 16; ++r) cinit[r] = cm;
            att::qkt(p0, p1, lds + blk * 8192, qr, cinit, lane);
            att::kmask(p0, p1, 0, hi_rel > 63 ? 63 : hi_rel, lane);
#pragma unroll
            for (int r = 0; r < 16; ++r) { p0[r] = __builtin_amdgcn_exp2f(p0[r]) * inv_l; p1[r] = __builtin_amdgcn_exp2f(p1[r]) * inv_l; }
#pragma unroll
            for (int tt = 0; tt < 2; ++tt)
#pragma unroll
                for (int r2 = 0; r2 < 4; ++r2) {
                    const float pa = tt ? p1[4 * r2] : p0[4 * r2], pb = tt ? p1[4 * r2 + 1] : p0[4 * r2 + 1], pc = tt ? p1[4 * r2 + 2] : p0[4 * r2 + 2], pd = tt ? p1[4 * r2 + 3] : p0[4 * r2 + 3];
                    float own = 2.f * (pa + pb + pc) + pd; const float other = att::xhalf(pd);
                    if (hi) own += other; else { own += prevx; prevx = other; }
                    imp_row[16 * blk + 8 * tt + 2 * r2 + hi] = own;
                }
            att::pv(c0, c1, p0, p1, lds + 32768 + blk * 8192, lane);
        }
#pragma unroll
        for (int r = 0; r < 16; ++r) { a0[r] = g_c * c0[r]; a1[r] = g_c * c1[r]; }
    }
    __syncthreads();
    {
        int tid2 = tid; asm volatile("" : "+v"(tid2));
        const int tok = tid2 >> 3, seg = tid2 & 7; const LAS float* ip = (const LAS float*)(lds + NSA_IMP); LAS unsigned* impf = (LAS unsigned*)(lds + NSA_IMPF);
        unsigned v[8];
#pragma unroll
        for (int i = 0; i < 8; ++i) { const int j = 8 * seg + i;
            float x = (ip[(0 * 64 + tok) * 65 + j] + ip[(1 * 64 + tok) * 65 + j]) + (ip[(2 * 64 + tok) * 65 + j] + ip[(3 * 64 + tok) * 65 + j]);
            if (j == 0 || j == cur || j == cur - 1) x = 1e4f;
            v[i] = (j > cur) ? 0u : __float_as_uint(x) + 1u; }
        if (tid < 2) ((LAS unsigned*)(lds + NSA_SELU))[tid] = 0u;
#pragma unroll
        for (int i = 0; i < 8; ++i) impf[tok * 65 + 8 * seg + i] = v[i];
        __syncthreads();
        int rank[8];
#pragma unroll
        for (int i = 0; i < 8; ++i) rank[i] = 0;
        unsigned long long key[8];
#pragma unroll
        for (int i = 0; i < 8; ++i) key[i] = ((unsigned long long)v[i] << 32) | (unsigned)(63 - (8 * seg + i));
        for (int k = 0; k < 64; ++k) { const unsigned long long x = ((unsigned long long)impf[tok * 65 + k] << 32) | (unsigned)(63 - k);
#pragma unroll
            for (int i = 0; i < 8; ++i) rank[i] += (x > key[i]) ? 1 : 0; }
        unsigned bits = 0;
#pragma unroll
        for (int i = 0; i < 8; ++i) bits |= (rank[i] < 16 ? 1u : 0u) << i;
        unsigned mlo = seg < 4 ? bits << (8 * seg) : 0u, mhi = seg >= 4 ? bits << (8 * (seg - 4)) : 0u;
#pragma unroll
        for (int o = 1; o < 8; o <<= 1) { mlo |= __shfl_xor(mlo, o); mhi |= __shfl_xor(mhi, o); }
        if (seg == 0) { LAS unsigned* sm = (LAS unsigned*)(lds + NSA_SELM); sm[2 * tok] = mlo; sm[2 * tok + 1] = mhi; }
        unsigned ulo = mlo, uhi = mhi;
#pragma unroll
        for (int o = 8; o < 64; o <<= 1) { ulo |= __shfl_xor(ulo, o); uhi |= __shfl_xor(uhi, o); }
        if (lane == 0) { __hip_atomic_fetch_or((LAS unsigned*)(lds + NSA_SELU), ulo, __ATOMIC_RELAXED, __HIP_MEMORY_SCOPE_WORKGROUP); __hip_atomic_fetch_or((LAS unsigned*)(lds + NSA_SELU) + 1, uhi, __ATOMIC_RELAXED, __HIP_MEMORY_SCOPE_WORKGROUP); }
        __syncthreads();
    }
    {
        int r32o = r32; asm volatile("" : "+v"(r32o));
        const LAS unsigned* sm = (const LAS unsigned*)(lds + NSA_SELM);
        const unsigned mlo = sm[2 * (s * 32 + r32o)], mhi = sm[2 * (s * 32 + r32o) + 1];
        const unsigned ulo = __builtin_amdgcn_readfirstlane(((const LAS unsigned*)(lds + NSA_SELU))[0]), uhi = __builtin_amdgcn_readfirstlane(((const LAS unsigned*)(lds + NSA_SELU))[1]);
        unsigned long long U = ((unsigned long long)uhi << 32) | ulo;
        if (cur < 63) U &= (1ull << (cur + 1)) - 1ull;
        U |= 1ull;
        const int wlo = cur - 8 < 0 ? 0 : cur - 8;
        const bf16_t* KSb = T.KS + bh * SEQ * HD; const bf16_t* VSb = T.VS + bh * SEQ * HD; const bf16_t* KWb = T.KW + bh * SEQ * HD; const bf16_t* VWb = T.VW + bh * SEQ * HD;
#define NSA_NEXT(it) (((it) < 64) ? ((((it) >= 63) ? 0ull : (U & ~((2ull << (it)) - 1ull))) != 0ull ? (int)__builtin_ctzll(U & ~((2ull << ((it) & 63)) - 1ull)) : 64 + wlo) : (((it) - 64 < cur) ? (it) + 1 : -1))
#define NSA_DMA(it, sl) do { const int _j = (it) & 63; const bool _w = (it) >= 64; \
        att::kv_dma((_w ? KWb : KSb) + (size_t)_j * 64 * HD, (_w ? VWb : VSb) + (size_t)_j * 64 * HD, lds + NSA_KS + (sl) * 16384, lds + NSA_KS + (sl) * 16384 + 8192, wid, lane); } while (0)
        LAS unsigned char* const accl = lds + 98304 + wid * 4096;
        att::acc_save(accl, a0, a1, lane);
        att::St st; att::st_init(st, att::SENT, 0.f);
        const int first_win = 64 + wlo;
        int it = 0, jl = 0, q1, q2, q3, sl = 0;
        NSA_DMA(0, 0);
        q1 = NSA_NEXT(0);  NSA_DMA(q1 >= 0 ? q1 : jl, 1); if (q1 >= 0) jl = q1;
        q2 = q1 >= 0 ? NSA_NEXT(q1) : -1; NSA_DMA(q2 >= 0 ? q2 : jl, 2); if (q2 >= 0) jl = q2;
        asm volatile("s_waitcnt vmcnt(2) lgkmcnt(0)\n\ts_barrier" ::: "memory");
        f32x16 pA0, pA1, pB0, pB1; int loA, hiA, loB = 0, hiB = 0; bool onA, onB = false;
#define NSA_QK(P0, P1, LO, HI, ON, item, ksl) do { const bool _w = (item) >= 64; const int _j = (item) & 63; \
            const bool _sel = ((_j < 32 ? (mlo >> _j) : (mhi >> (_j - 32))) & 1u) != 0u; \
            const int _lo = _w ? t - 511 - 64 * _j : 0, _hi = t - 64 * _j; \
            ON = (_w || _sel) && _hi >= 0 && _lo <= 63; LO = _lo < 0 ? 0 : _lo; HI = _hi > 63 ? 63 : _hi; \
            const float _mref = ((item) == first_win) ? att::SENT : st.mhat; \
            const float _cm = ON ? ((_mref == att::SENT) ? 0.f : -_mref) : att::NEG_INF; f32x16 _c; \
            _Pragma("unroll") for (int _r = 0; _r < 16; ++_r) _c[_r] = _cm; \
            att::qkt(P0, P1, lds + NSA_KS + (ksl) * 16384, qr, _c, lane); } while (0)
#define NSA_FIN(C0, C1, LO, HI, ON, vsl, N0, N1, fixnext) do { \
            if (__any(ON && (LO > 0 || HI < 63))) att::kmask(C0, C1, LO, HI, lane); \
            const float _rm = att::rowmax(C0, C1); const bool _fresh = st.mhat == att::SENT, _need = _fresh ? (_rm > att::NEG_INF) : (_rm > att::THR); \
            if (__any(_need)) { const float _dl = _need ? _rm : 0.f, _f = (_need && !_fresh) ? __builtin_amdgcn_exp2f(-_dl) : 1.f; \
                st.mhat = _need ? (_fresh ? _dl : st.mhat + _dl) : st.mhat; st.l *= _f; \
                _Pragma("unroll") for (int _r = 0; _r < 16; ++_r) { C0[_r] -= _dl; C1[_r] -= _dl; st.o0[_r] *= _f; st.o1[_r] *= _f; } \
                if (fixnext) { _Pragma("unroll") for (int _r = 0; _r < 16; ++_r) { N0[_r] -= _dl; N1[_r] -= _dl; } } } \
            float _sa = 0.f, _sb = 0.f; \
            _Pragma("unroll") for (int _r = 0; _r < 16; ++_r) { C0[_r] = __builtin_amdgcn_exp2f(C0[_r]); C1[_r] = __builtin_amdgcn_exp2f(C1[_r]); _sa += C0[_r]; _sb += C1[_r]; } \
            st.l += _sa + _sb; att::pv(st.o0, st.o1, C0, C1, lds + NSA_KS + (vsl) * 16384 + 8192, lane); } while (0)
#define NSA_STEP(C0, C1, LOC, HIC, ONC, N0, N1, LON, HIN, ONN) do { \
            q3 = q2 >= 0 ? NSA_NEXT(q2) : -1; NSA_DMA(q3 >= 0 ? q3 : jl, (sl + 3) & 3); if (q3 >= 0) jl = q3; \
            if (it == first_win) { f32x16 _t0, _t1; att::acc_load(accl, _t0, _t1, lane); att::fold(_t0, _t1, st, g_s); att::acc_save(accl, _t0, _t1, lane); att::st_init(st, att::SENT, 0.f); } \
            const bool _hn = q1 >= 0; \
            if (_hn) NSA_QK(N0, N1, LON, HIN, ONN, q1, (sl + 1) & 3); \
            NSA_FIN(C0, C1, LOC, HIC, ONC, sl, N0, N1, (_hn && q1 != first_win)); \
            asm volatile("s_waitcnt vmcnt(2) lgkmcnt(0)\n\ts_barrier" ::: "memory"); \
            it = q1; q1 = q2; q2 = q3; sl = (sl + 1) & 3; } while (0)
        NSA_QK(pA0, pA1, loA, hiA, onA, 0, 0);
        for (;;) {
            NSA_STEP(pA0, pA1, loA, hiA, onA, pB0, pB1, loB, hiB, onB); if (it < 0) break;
            NSA_STEP(pB0, pB1, loB, hiB, onB, pA0, pA1, loA, hiA, onA); if (it < 0) break;
        }
        att::acc_load(accl, a0, a1, lane);
        att::fold(a0, a1, st, g_w);
        ATT_WAIT_BAR();
#undef NSA_QK
#undef NSA_FIN
#undef NSA_STEP
#undef NSA_NEXT
#undef NSA_DMA
    }
    att::store_o(T.O + qoff, a0, a1, lane);
}

__device__ __forceinline__ void ln_apply(f32x4 (&v)[4], const float* gain, const float* bias, int lane) {
    float s = 0.f;
#pragma unroll
    for (int j = 0; j < 4; ++j) s += (v[j][0] + v[j][1]) + (v[j][2] + v[j][3]);
    const float mean = wave_sum(s) * (1.f / DM); float s2 = 0.f;
#pragma unroll
    for (int j = 0; j < 4; ++j) { v[j] = v[j] - mean; s2 += (v[j][0] * v[j][0] + v[j][1] * v[j][1]) + (v[j][2] * v[j][2] + v[j][3] * v[j][3]); }
    const float rstd = 1.f / sqrtf(wave_sum(s2) * (1.f / DM) + LN_EPS);
#pragma unroll
    for (int j = 0; j < 4; ++j) { const f32x4 gg = *(const f32x4*)(gain + 4 * lane + 256 * j), bb = *(const f32x4*)(bias + 4 * lane + 256 * j); v[j] = v[j] * rstd * gg + bb; }
}
__device__ __forceinline__ void store_row_bf16(bf16_t* orow, const f32x4 (&v)[4], int lane) {
#pragma unroll
    for (int j = 0; j < 4; ++j) { u32x2 w; w.x = cvt_pk_bf16(v[j][0], v[j][1]); w.y = cvt_pk_bf16(v[j][2], v[j][3]); *(u32x2*)(orow + 4 * lane + 256 * j) = w; }
}
__device__ __forceinline__ void load_row_bf16(f32x4 (&v)[4], const bf16_t* row, int lane) {
#pragma unroll
    for (int j = 0; j < 4; ++j) { const u32x2 w = *(const u32x2*)(row + 4 * lane + 256 * j); v[j][0] = bf_lo(w.x); v[j][1] = bf_hi(w.x); v[j][2] = bf_lo(w.y); v[j][3] = bf_hi(w.y); }
}
__device__ __forceinline__ void moe_offsets(unsigned* ctl, int (&toff)[9]) {
    int acc = 0;
#pragma unroll
    for (int e = 0; e < 8; ++e) { toff[e] = acc; const int c = (int)__builtin_amdgcn_readfirstlane(__hip_atomic_load(ctl + CW_CNT + 64 * e, __ATOMIC_RELAXED, __HIP_MEMORY_SCOPE_AGENT)); acc += (c + 255) >> 8; }
    toff[8] = acc;
}
struct HBasePlain { bf16_t* H; __device__ __forceinline__ bf16_t* operator()(int pm) const { return H + (size_t)pm * 256 * DFF; } };
struct HBaseMoe { bf16_t* A; bf16_t* B;
    __device__ __forceinline__ bf16_t* operator()(int t) const { const int s = t >= 256 ? 64 + (t - 256) : (t & 63); const bool useB = t >= 256 || ((t >> 6) & 1); return (useB ? B : A) + (size_t)s * 256 * DFF; } };
struct MoeExp { int t1, t2, t3, t4, t5, t6, t7;
    __device__ __forceinline__ int operator()(int pm) const { return (pm >= t1) + (pm >= t2) + (pm >= t3) + (pm >= t4) + (pm >= t5) + (pm >= t6) + (pm >= t7); } };
struct BasesMoeGU { const bf16_t* XG; const bf16_t* W; MoeExp ex;
    __device__ __forceinline__ const char* a(const pg8::Unit& u) const { return (const char*)XG + (size_t)u.pm * 256 * 1024 * 2; }
    __device__ __forceinline__ const char* b(const pg8::Unit& u) const { return (const char*)W + (size_t)ex(u.pm) * ((size_t)2 * DFF * 1024 * 2) + (size_t)u.pn * 256 * 1024 * 2; } };
struct BasesMoeDN { HBaseMoe hb; const bf16_t* W; MoeExp ex;
    __device__ __forceinline__ const char* a(const pg8::Unit& u) const { return (const char*)hb(u.pm); }
    __device__ __forceinline__ const char* b(const pg8::Unit& u) const { return (const char*)W + (size_t)ex(u.pm) * ((size_t)1024 * DFF * 2) + (size_t)u.pn * 256 * DFF * 2; } };
struct BasesCmp { const bf16_t* A; const bf16_t* Bt;
    __device__ __forceinline__ const char* a(const pg8::Unit& u) const { return (const char*)A + (size_t)u.pm * 256 * 1024 * 2; }
    __device__ __forceinline__ const char* b(const pg8::Unit& u) const { return (const char*)Bt + ((u.pm >= 32) ? (size_t)MiB : (size_t)0); } };
struct EpiCmp {
    static constexpr bool PERM = true;
    bf16_t* O; const float* bias;
    __device__ __forceinline__ void operator()(const f32x4 (&acc)[2][2][4][2], const pg8::Unit& u, int wr, int wc, int fr, int fq) const {
        pg8::EpiBf16<1> e{O, 256, bias + ((u.pm >= 32) ? 256 : 0)}; e(acc, u, wr, wc, fr, fq);
    }
};

__device__ const double ROPE_INV[32] = {1.0, 0.7498942093324559, 0.5623413251903491, 0.4216965034285822, 0.31622776601683794, 0.23713737056616552, 0.1778279410038923, 0.1333521432163324,
    0.1, 0.07498942093324558, 0.05623413251903491, 0.042169650342858224, 0.03162277660168379, 0.023713737056616554, 0.01778279410038923, 0.01333521432163324,
    0.01, 0.007498942093324558, 0.005623413251903491, 0.004216965034285823, 0.0031622776601683794, 0.0023713737056616554, 0.0017782794100389228, 0.001333521432163324,
    0.001, 0.0007498942093324559, 0.0005623413251903491, 0.00042169650342858224, 0.00031622776601683794, 0.00023713737056616554, 0.00017782794100389227, 0.0001333521432163324};

constexpr int NPH = 20;
struct Args { const float* in[21]; float* out; unsigned char* ws; int ph_lo, ph_hi, li, pad; };
enum { I_X = 0, I_AWIN, I_AWOUT, I_ASINK, I_BWIN, I_BWOUT, I_POSK, I_POSV, I_CKW1, I_CKW2, I_CVW1, I_CVW2, I_FG, I_FU, I_FD, I_ROUTER, I_MG, I_MU, I_MD, I_LNG, I_LNB };

__global__ void __launch_bounds__(512, 2) fwd(Args args) {
    extern __shared__ __attribute__((aligned(16))) unsigned char lds_raw[];
    LAS unsigned char* lds = (LAS unsigned char*)lds_raw;
    const int tid = threadIdx.x, lane = tid & 63, wave = __builtin_amdgcn_readfirstlane(tid >> 6);
    const int G = gridDim.x, wg = blockIdx.x, gw = wg * 8 + wave, NGW = G * 8;
    unsigned char* ws = args.ws;
    unsigned* ctl = (unsigned*)(ws + WS_CTL);
    const int lo = args.ph_lo, hi = args.ph_hi;
    volatile LAS unsigned* MISC = (volatile LAS unsigned*)(lds + LDSCTL_OFF);
    if (tid < 64) MISC[tid] = 0u;
    __syncthreads();
    XcdBarrier bar; bar.bar = ctl + CW_BAR + args.li * XCD_BAR_WORDS; bar.x = 0; bar.st = MISC + 8;
    if (hi - lo > 1) bar = xcd_barrier_post(ctl + CW_BAR + args.li * XCD_BAR_WORDS, MISC + 8);
#ifndef PHMASK
#define PHMASK 0xFFFFFFFFu
#endif
#define IN(k) (((PHMASK >> (k)) & 1u) && lo <= (k) && (k) < hi)
#define SEAM(k) do { if (IN(k) && IN((k) + 1)) xcd_barrier(bar); } while (0)
    bf16_t* const WA_IN = (bf16_t*)(ws + WS_WA_IN); bf16_t* const WA_OUT = (bf16_t*)(ws + WS_WA_OUT); bf16_t* const WB_IN = (bf16_t*)(ws + WS_WB_IN); bf16_t* const WB_OUT = (bf16_t*)(ws + WS_WB_OUT);
    bf16_t* const CW1 = (bf16_t*)(ws + WS_CW1K); bf16_t* const FFN_GU = (bf16_t*)(ws + WS_FFN_GU); bf16_t* const FFN_D = (bf16_t*)(ws + WS_FFN_D);
    bf16_t* const MOE_GU = (bf16_t*)(ws + WS_MOE_GU); bf16_t* const MOE_D = (bf16_t*)(ws + WS_MOE_D);
    float* const ROPE = (float*)(ws + WS_ROPE); float* const POSB = (float*)(ws + WS_MISC); bf16_t* const W2T = (bf16_t*)(ws + WS_MISC + 4096);
    float* const GATES = (float*)(ws + WS_GATES); bf16_t* const KCC = (bf16_t*)(ws + WS_KCC);
    bf16_t* const XB = (bf16_t*)(ws + WS_XB); bf16_t* const QB = (bf16_t*)(ws + WS_Q); bf16_t* const KVB = (bf16_t*)(ws + WS_KV);
    bf16_t* const HFF = (bf16_t*)(ws + WS_HFF); bf16_t* const X1B = (bf16_t*)(ws + WS_X1B); bf16_t* const CHID = (bf16_t*)(ws + WS_CHID);
    bf16_t* const X3B = (bf16_t*)(ws + WS_X3B); bf16_t* const XG = (bf16_t*)(ws + WS_XG); bf16_t* const HMOE = (bf16_t*)(ws + WS_HMOE);
    int* const ROUTE = (int*)(ws + WS_ROUTE);
    bf16_t* const Y16 = (bf16_t*)args.out;
    bf16_t* const OB0 = KVB + 2 * (KV_STRIDE_B / 2);
    constexpr size_t KVS = KV_STRIDE_B / 2;

    if (IN(0)) {
        LAS float* scr = (LAS float*)(lds + wave * 16384);
        constexpr int I_A1 = 16 * 48, I_A2 = 16 * 32, I_B1 = 16 * 82, I_B2 = 16 * 32, I_C1 = 32 * 8, I_C2 = 4 * 2, I_F = 16 * 112, I_FDN = 56 * 32, I_ME = 2 * I_F + I_FDN;
        constexpr int NITEMS = I_A1 + I_A2 + I_B1 + I_B2 + 2 * I_C1 + 2 * I_C2 + 2 * I_F + I_FDN + 8 * I_ME;
        for (int it = gw; it < NITEMS; it += NGW) {
            int r = it;
            if (r < I_A1) { const int n0 = 32 * (r % 48); transpose_item(args.in[I_AWIN], 1024, 1536, WA_IN, 0, n0 < 1280 ? 1 : 0, scr, r, lane); continue; } r -= I_A1;
            if (r < I_A2) { transpose_item(args.in[I_AWOUT], 1024, 1024, WA_OUT, 0, 0, scr, r, lane); continue; } r -= I_A2;
            if (r < I_B1) { const int n0 = 32 * (r % 82); const bool rp = n0 < 1280 || (n0 >= 1536 && n0 < 1792) || (n0 >= 2048 && n0 < 2304);
                transpose_item(args.in[I_BWIN], 1024, NSA_IN, WB_IN, 0, rp ? 1 : 0, scr, r, lane); continue; } r -= I_B1;
            if (r < I_B2) { transpose_item(args.in[I_BWOUT], 1024, 1024, WB_OUT, 0, 0, scr, r, lane); continue; } r -= I_B2;
            if (r < I_C1) { transpose_item(args.in[I_CKW1], 2048, 256, CW1, 0, 0, scr, r, lane); continue; } r -= I_C1;
            if (r < I_C1) { transpose_item(args.in[I_CVW1], 2048, 256, CW1, 256, 0, scr, r, lane); continue; } r -= I_C1;
            if (r < I_C2) { transpose_item(args.in[I_CKW2], 256, 64, W2T, 0, 1, scr, r, lane);     continue; } r -= I_C2;
            if (r < I_C2) { transpose_item(args.in[I_CVW2], 256, 64, W2T, 64, 0, scr, r, lane); continue; } r -= I_C2;
            if (r < I_F) { transpose_item(args.in[I_FG], 1024, DFF, FFN_GU, 0, 2, scr, r, lane); continue; } r -= I_F;
            if (r < I_F) { transpose_item(args.in[I_FU], 1024, DFF, FFN_GU, 0, 3, scr, r, lane); continue; } r -= I_F;
            if (r < I_FDN) { transpose_item(args.in[I_FD], DFF, 1024, FFN_D, 0, 0, scr, r, lane); continue; } r -= I_FDN;
            const int e = r / I_ME; r -= e * I_ME;
            if (r < I_F) { transpose_item(args.in[I_MG] + (size_t)e * 1024 * DFF, 1024, DFF, MOE_GU + (size_t)e * 2 * DFF * 1024, 0, 2, scr, r, lane); continue; } r -= I_F;
            if (r < I_F) { transpose_item(args.in[I_MU] + (size_t)e * 1024 * DFF, 1024, DFF, MOE_GU + (size_t)e * 2 * DFF * 1024, 0, 3, scr, r, lane); continue; } r -= I_F;
            transpose_item(args.in[I_MD] + (size_t)e * DFF * 1024, DFF, 1024, MOE_D + (size_t)e * 1024 * DFF, 0, 0, scr, r, lane);
        }
        for (int m = gw; m < TTOK; m += NGW) {
            f32x4 v[4];
#pragma unroll
            for (int j = 0; j < 4; ++j) v[j] = *(const f32x4*)(args.in[I_X] + (size_t)m * DM + 4 * lane + 256 * j);
            store_row_bf16(XB + (size_t)m * DM, v, lane);
        }
        for (int i = wg * 512 + tid; i < SEQ * 32; i += G * 512) {
            const int t = i >> 5, f = i & 31; const double rev = (double)t * ROPE_INV[f] * 0.15915494309189535; const float fr = (float)(rev - __builtin_rint(rev));
            ROPE[t * 64 + f] = __builtin_amdgcn_cosf(fr); ROPE[t * 64 + 32 + f] = __builtin_amdgcn_sinf(fr);
        }
        for (int o = gw; o < 512; o += NGW) {
            const float* pos = args.in[o < 256 ? I_POSK : I_POSV]; const float* w1 = args.in[o < 256 ? I_CKW1 : I_CVW1]; const int n = o & 255; float s = 0.f;
            for (int k = lane; k < 2048; k += 64) s += pos[k] * w1[(size_t)k * 256 + n];
            s = wave_sum(s); if (lane == 0) POSB[o] = s;
        }
        for (int i = wg * 512 + tid; i < (NSA_IN_PAD - NSA_IN) * 1024 / 8; i += G * 512) *(u32x4*)(WB_IN + (size_t)NSA_IN * 1024 + (size_t)i * 8) = (u32x4){0u, 0u, 0u, 0u};
    }
    SEAM(0);
    if (IN(1)) {
        pg8::Gemm g{1024, 1024}; pg8::StaticOrder S; S.init(128, 6, G, wg, 0);
        pg8::EpiProj E{QB, KVB, KVS, nullptr, ROPE, 1, -1, 0};
        pg8::gemm_phase(lds, g, S, E, pg8::BasesPlain{XB, WA_IN, 1024, 1024});
    }
    SEAM(1);
    if (IN(2)) {
        for (int u = wg; u < 2048; u += G) { const int bk = u & 31; swa_unit(lds, bk >> 2, bk & 3, u >> 5, QB, KVB, KVB + KVS, OB0, args.in[I_ASINK]); }
    }
    SEAM(2);
    if (IN(3)) {
        pg8::Gemm g{1024, 1024}; pg8::StaticOrder S; S.init(128, 4, G, wg, 0);
        pg8::EpiResid E{Y16, XB};
        pg8::gemm_phase(lds, g, S, E, pg8::BasesPlain{OB0, WA_OUT, 1024, 1024});
    }
    SEAM(3);
    if (IN(4)) {
        for (int m = gw; m < TTOK; m += NGW) { f32x4 v[4]; load_row_bf16(v, Y16 + (size_t)m * DM, lane);
            ln_apply(v, args.in[I_LNG], args.in[I_LNB], lane); store_row_bf16(X1B + (size_t)m * DM, v, lane); }
    }
    SEAM(4);
    if (IN(5)) {
        pg8::Gemm g{1024, 1024}; pg8::StaticOrder S; S.init(128, 28, G, wg, 0);
        pg8::EpiSwiglu<HBasePlain> E{HBasePlain{HFF}, DFF};
        pg8::gemm_phase(lds, g, S, E, pg8::BasesPlain{X1B, FFN_GU, 1024, 1024});
    }
    SEAM(5);
    if (IN(6)) {
        pg8::Gemm g{DFF, DFF}; pg8::StaticOrder S; S.init(128, 4, G, wg, 0);
        pg8::EpiResid E{Y16, X1B};
        pg8::gemm_phase(lds, g, S, E, pg8::BasesPlain{HFF, FFN_D, DFF, DFF});
    }
    SEAM(6);
    if (IN(7)) {
        for (int m = gw; m < TTOK; m += NGW) { f32x4 v[4]; load_row_bf16(v, Y16 + (size_t)m * DM, lane);
            ln_apply(v, args.in[I_LNG] + 1024, args.in[I_LNB] + 1024, lane); store_row_bf16(XB + (size_t)m * DM, v, lane); }
    }
    SEAM(7);
    if (IN(8)) {
        pg8::Gemm g{1024, 1024}; pg8::StaticOrder S; S.init(128, 11, G, wg, 0);
        pg8::EpiProj E{QB, KVB, KVS, GATES, ROPE, 0x15, 10, 1};
        pg8::gemm_phase(lds, g, S, E, pg8::BasesPlain{XB, WB_IN, 1024, 1024});
    }
    SEAM(8);
    if (IN(9)) {
        pg8::Gemm g{1024, 2048}; pg8::StaticOrder S; S.init(64, 1, G, wg, 0);
        EpiCmp E{CHID, POSB};
        pg8::gemm_phase(lds, g, S, E, BasesCmp{KVB, CW1});
    }
    SEAM(9);
    if (IN(10)) {
        const int r32 = lane & 31, hh = lane >> 5;
        for (int task = gw; task < 512; task += NGW) {
            const int row0 = task * 32, which = row0 >> 13; const bf16_t* Hrow = CHID + (size_t)(row0 + r32) * 256; const bf16_t* Wt = W2T + which * 64 * 256;
            f32x16 c0, c1;
#pragma unroll
            for (int r = 0; r < 16; ++r) { c0[r] = 0.f; c1[r] = 0.f; }
#pragma unroll
            for (int ks = 0; ks < 16; ++ks) { const bf16x8 a = *(const bf16x8*)(Hrow + ks * 16 + hh * 8), b0 = *(const bf16x8*)(Wt + r32 * 256 + ks * 16 + hh * 8), b1 = *(const bf16x8*)(Wt + (32 + r32) * 256 + ks * 16 + hh * 8);
                c0 = __builtin_amdgcn_mfma_f32_32x32x16_bf16(a, b0, c0, 0, 0, 0); c1 = __builtin_amdgcn_mfma_f32_32x32x16_bf16(a, b1, c1, 0, 0, 0); }
#pragma unroll
            for (int r = 0; r < 16; ++r) { const int grow = row0 + (r & 3) + 8 * (r >> 2) + 4 * hh; const bool z = (grow & 255) == 255;
                KCC[(size_t)grow * 64 + r32] = (bf16_t)f2bf(z ? 0.f : c0[r]); KCC[(size_t)grow * 64 + 32 + r32] = (bf16_t)f2bf(z ? 0.f : c1[r]); }
        }
    }
    SEAM(10);
    if (IN(11)) {
        const NsaT T{QB, X1B, KVB + 2 * KVS, KVB + 3 * KVS, KVB + 4 * KVS, KVB + 5 * KVS, KCC, KCC + (size_t)8192 * 64, GATES};
        for (int u = wg; u < 2048; u += G) { const int bk = u & 31, rr = u >> 5, rnd = rr >> 3, q = rr & 7;
            const int tile = 63 - (8 * rnd + ((rnd & 1) ? 7 - q : q)); nsa_unit(lds, bk >> 2, bk & 3, tile, T); }
    }
    SEAM(11);
    if (IN(12)) {
        pg8::Gemm g{1024, 1024}; pg8::StaticOrder S; S.init(128, 4, G, wg, 0);
        pg8::EpiResid E{Y16, XB};
        pg8::gemm_phase(lds, g, S, E, pg8::BasesPlain{X1B, WB_OUT, 1024, 1024});
    }
    SEAM(12);
    if (IN(13)) {
        f32x4 rw[16][2];
#pragma unroll
        for (int j = 0; j < 4; ++j)
#pragma unroll
            for (int k = 0; k < 4; ++k) { const float* rp = args.in[I_ROUTER] + (size_t)(4 * lane + 256 * j + k) * 8; rw[4 * j + k][0] = *(const f32x4*)rp; rw[4 * j + k][1] = *(const f32x4*)(rp + 4); }
        LAS int* cntl = (LAS int*)lds;
        for (int u = wg; u < TTOK / 128; u += G) {
            int c[8];
#pragma unroll
            for (int e = 0; e < 8; ++e) c[e] = 0;
            int me1 = 0, me2 = 0, ms1 = 0, ms2 = 0; float mw1 = 0.f, mw2 = 0.f;
            for (int i = 0; i < 16; ++i) {
                const int m = u * 128 + wave * 16 + i; f32x4 v[4]; load_row_bf16(v, Y16 + (size_t)m * DM, lane);
                ln_apply(v, args.in[I_LNG] + 2048, args.in[I_LNB] + 2048, lane); store_row_bf16(X3B + (size_t)m * DM, v, lane);
                float lg[8];
#pragma unroll
                for (int e = 0; e < 8; ++e) lg[e] = 0.f;
#pragma unroll
                for (int j = 0; j < 4; ++j)
#pragma unroll
                    for (int k = 0; k < 4; ++k) { const float x = v[j][k];
#pragma unroll
                        for (int e = 0; e < 4; ++e) { lg[e] += x * rw[4 * j + k][0][e]; lg[4 + e] += x * rw[4 * j + k][1][e]; } }
#pragma unroll
                for (int e = 0; e < 8; ++e) lg[e] = wave_sum(lg[e]);
                int e1 = 0; float v1 = lg[0];
#pragma unroll
                for (int e = 1; e < 8; ++e) if (lg[e] > v1) { v1 = lg[e]; e1 = e; }
                int e2 = -1; float v2 = 0.f;
#pragma unroll
                for (int e = 0; e < 8; ++e) if (e != e1 && (e2 < 0 || lg[e] > v2)) { v2 = lg[e]; e2 = e; }
                const float ex = __expf(v2 - v1), w1 = 1.f / (1.f + ex), w2 = ex * w1;
                int s1 = 0, s2 = 0;
#pragma unroll
                for (int e = 0; e < 8; ++e) { if (e == e1) s1 = c[e]; if (e == e2) s2 = c[e]; c[e] += (e == e1 || e == e2) ? 1 : 0; }
                if (lane == i) { me1 = e1; me2 = e2; ms1 = s1; ms2 = s2; mw1 = w1; mw2 = w2; }
            }
            __syncthreads();
            if (lane < 8) { int cv = 0;
#pragma unroll
                for (int e = 0; e < 8; ++e) if (lane == e) cv = c[e];
                cntl[wave * 8 + lane] = cv; }
            __syncthreads();
            if (tid < 8) { int tot = 0;
#pragma unroll
                for (int w = 0; w < 8; ++w) tot += cntl[w * 8 + tid];
                int base = (int)__hip_atomic_fetch_add(ctl + CW_CNT + 64 * tid, (unsigned)tot, __ATOMIC_RELAXED, __HIP_MEMORY_SCOPE_AGENT);
#pragma unroll
                for (int w = 0; w < 8; ++w) { cntl[64 + w * 8 + tid] = base; base += cntl[w * 8 + tid]; } }
            __syncthreads();
            if (lane < 16) { int* rp = ROUTE + (size_t)(u * 128 + wave * 16 + lane) * 8;
                rp[0] = me1; rp[1] = me2; rp[2] = cntl[64 + wave * 8 + me1] + ms1; rp[3] = cntl[64 + wave * 8 + me2] + ms2; ((float*)rp)[4] = mw1; ((float*)rp)[5] = mw2; }
        }
    }
    SEAM(13);
    if (IN(14)) {
        int toff[9]; moe_offsets(ctl, toff);
        for (int m = gw; m < TTOK; m += NGW) {
            const int* rp = ROUTE + (size_t)m * 8; const int e1 = __builtin_amdgcn_readfirstlane(rp[0]), e2 = __builtin_amdgcn_readfirstlane(rp[1]), s1 = __builtin_amdgcn_readfirstlane(rp[2]), s2 = __builtin_amdgcn_readfirstlane(rp[3]);
            int t1 = 0, t2 = 0;
#pragma unroll
            for (int e = 0; e < 8; ++e) { if (e == e1) t1 = toff[e]; if (e == e2) t2 = toff[e]; }
            const u32x4 a = *(const u32x4*)(X3B + (size_t)m * DM + lane * 8), b = *(const u32x4*)(X3B + (size_t)m * DM + 512 + lane * 8);
            bf16_t* d1 = XG + ((size_t)t1 * 256 + s1) * DM; bf16_t* d2 = XG + ((size_t)t2 * 256 + s2) * DM;
            *(u32x4*)(d1 + lane * 8) = a; *(u32x4*)(d1 + 512 + lane * 8) = b; *(u32x4*)(d2 + lane * 8) = a; *(u32x4*)(d2 + 512 + lane * 8) = b;
        }
    }
    SEAM(14);
    if (IN(15)) {
        int toff[9]; moe_offsets(ctl, toff); const int rem = toff[8] - 256;
        pg8::Gemm g{1024, 1024}; pg8::StaticOrder S; S.init(128 + rem, 28, G, wg, 0, 128, 128);
        pg8::EpiSwiglu<HBaseMoe> E{HBaseMoe{HMOE, (bf16_t*)args.out}, DFF};
        pg8::gemm_phase(lds, g, S, E, BasesMoeGU{XG, MOE_GU, MoeExp{toff[1], toff[2], toff[3], toff[4], toff[5], toff[6], toff[7]}});
    }
    SEAM(15);
    if (IN(16)) {
        int toff[9]; moe_offsets(ctl, toff);
        pg8::Gemm g{DFF, DFF}; pg8::StaticOrder S; S.init(128, 4, G, wg, 0);
        pg8::EpiBf16<0> E{XG, 1024, nullptr};
        pg8::gemm_phase(lds, g, S, E, BasesMoeDN{HBaseMoe{HMOE, (bf16_t*)args.out}, MOE_D, MoeExp{toff[1], toff[2], toff[3], toff[4], toff[5], toff[6], toff[7]}});
    }
    SEAM(16);
    if (IN(17)) {
        int toff[9]; moe_offsets(ctl, toff); const int rem = toff[8] - 256; const MoeExp ex{toff[1], toff[2], toff[3], toff[4], toff[5], toff[6], toff[7]};
        { pg8::Gemm g{DFF, DFF}; pg8::StaticOrder S; S.init(rem, 4, G, wg, 256);
          pg8::EpiBf16<0> E{XG, 1024, nullptr};
          pg8::gemm_phase(lds, g, S, E, BasesMoeDN{HBaseMoe{HMOE, (bf16_t*)args.out}, MOE_D, ex}); }
        { pg8::Gemm g{1024, 1024}; pg8::SkewOrder S; S.init(128, 28, G, wg, 128); S.nskip = (4 * rem + 7) & ~7; S.skip = 3;
          pg8::EpiSwiglu<HBaseMoe> E{HBaseMoe{HMOE, (bf16_t*)args.out}, DFF};
          pg8::gemm_phase(lds, g, S, E, BasesMoeGU{XG, MOE_GU, ex}); }
    }
    SEAM(17);
    if (IN(18)) {
        int toff[9]; moe_offsets(ctl, toff);
        pg8::Gemm g{DFF, DFF}; pg8::StaticOrder S; S.init(128, 4, G, wg, 128);
        pg8::EpiBf16<0> E{XG, 1024, nullptr};
        pg8::gemm_phase(lds, g, S, E, BasesMoeDN{HBaseMoe{HMOE, (bf16_t*)args.out}, MOE_D, MoeExp{toff[1], toff[2], toff[3], toff[4], toff[5], toff[6], toff[7]}});
    }
    SEAM(18);
    if (IN(19)) {
        int toff[9]; moe_offsets(ctl, toff);
        for (int m = gw; m < TTOK; m += NGW) {
            const int* rp = ROUTE + (size_t)m * 8; const int e1 = __builtin_amdgcn_readfirstlane(rp[0]), e2 = __builtin_amdgcn_readfirstlane(rp[1]), s1 = __builtin_amdgcn_readfirstlane(rp[2]), s2 = __builtin_amdgcn_readfirstlane(rp[3]);
            const float w1 = __uint_as_float(__builtin_amdgcn_readfirstlane(rp[4])), w2 = __uint_as_float(__builtin_amdgcn_readfirstlane(rp[5]));
            int t1 = 0, t2 = 0;
#pragma unroll
            for (int e = 0; e < 8; ++e) { if (e == e1) t1 = toff[e]; if (e == e2) t2 = toff[e]; }
            f32x4 x[4], y1[4], y2[4];
            load_row_bf16(x, X3B + (size_t)m * DM, lane); load_row_bf16(y1, XG + ((size_t)t1 * 256 + s1) * DM, lane); load_row_bf16(y2, XG + ((size_t)t2 * 256 + s2) * DM, lane);
#pragma unroll
            for (int j = 0; j < 4; ++j) x[j] = x[j] * DN_ALPHA + (y1[j] * w1 + y2[j] * w2);
            ln_apply(x, args.in[I_LNG] + 3072, args.in[I_LNB] + 3072, lane);
#pragma unroll
            for (int j = 0; j < 4; ++j) *(f32x4*)(args.out + (size_t)m * DM + 4 * lane + 256 * j) = x[j];
        }
    }
#undef IN
#undef SEAM
}

#ifndef MK_PER_PHASE
#define MK_PER_PHASE 0
#endif
extern "C" void kernel_launch(void* const* d_in, const int* in_sizes, int n_in, void* d_out, int out_size, void* d_ws, size_t ws_size, hipStream_t stream) {
    static int grid = 0;
    if (grid == 0) {
        if (n_in != 21 || in_sizes[0] != TTOK * DM || out_size != TTOK * DM || ws_size < WS_END) { fprintf(stderr, "kernel_launch: unexpected shapes (n_in %d, ws %zu < %zu?)\n", n_in, ws_size, (size_t)WS_END); grid = -1; return; }
        int dev = 0, cus = 0;
        if (hipGetDevice(&dev) != hipSuccess || hipDeviceGetAttribute(&cus, hipDeviceAttributeMultiprocessorCount, dev) != hipSuccess) { grid = -1; return; }
        if (hipFuncSetAttribute((const void*)fwd, hipFuncAttributeMaxDynamicSharedMemorySize, LDS_BYTES) != hipSuccess) { fprintf(stderr, "kernel_launch: hipFuncSetAttribute failed\n"); grid = -1; return; }
        int per_cu = 0;
        if (hipOccupancyMaxActiveBlocksPerMultiprocessor(&per_cu, (const void*)fwd, 512, LDS_BYTES) != hipSuccess || per_cu < 1) { fprintf(stderr, "kernel_launch: occupancy query says %d\n", per_cu); }
        (void)hipGetLastError();
        grid = cus;
    }
    if (grid < 0) return;
    (void)hipMemsetAsync((char*)d_ws + WS_CTL, 0, CTL_ZERO_BYTES, stream);
    Args a{};
    for (int i = 0; i < 21; ++i) a.in[i] = (const float*)d_in[i];
    a.out = (float*)d_out; a.ws = (unsigned char*)d_ws;
#if MK_PER_PHASE
    for (int p = 0; p < NPH; ++p) { a.ph_lo = p; a.ph_hi = p + 1; hipLaunchKernelGGL(fwd, dim3(grid), dim3(512), LDS_BYTES, stream, a); }
#elif defined(DUP_LO)
    a.ph_lo = 0; a.ph_hi = DUP_HI; a.li = 0; hipLaunchKernelGGL(fwd, dim3(grid), dim3(512), LDS_BYTES, stream, a);
    a.ph_lo = DUP_LO; a.ph_hi = NPH; a.li = 1; hipLaunchKernelGGL(fwd, dim3(grid), dim3(512), LDS_BYTES, stream, a);
#else
    a.ph_lo = 0; a.ph_hi = NPH; hipLaunchKernelGGL(fwd, dim3(grid), dim3(512), LDS_BYTES, stream, a);
#endif
}
```
